# Optimizing an MI355X kernel written in HIP

```python
import jax
import jax.numpy as jnp
from jax import lax
import numpy as np

D_MODEL = 2048
BATCH = 16
SEQ = 256
DEPTH = 2
DEC_BATCH = 8
DEC_SEQ = 4096
PAST_LEN = 512

GRID_W = 64
HEAD_DIM = 128
A_HEADS = 8
A_KV_HEADS = 2
A_GROUP = A_HEADS // A_KV_HEADS
A_WIDTH = A_HEADS * HEAD_DIM
A_KV_WIDTH = A_KV_HEADS * HEAD_DIM
WINDOW = 128
ATT_BLOCK = 128
ROPE_THETA = 10000.0
MASK_VALUE = -1e30
B_HEADS = 4
B_DK = 128
B_DV = 128
B_KEY_WIDTH = B_HEADS * B_DK
B_WIDTH = B_HEADS * B_DV
B_CHUNK = 32
C_GROUPS = 4
C_CHUNK = 128
C_WIDTH = D_MODEL // 4
C_GROUP_DIM = C_WIDTH // C_GROUPS
MIX_WIDTH = A_WIDTH + B_WIDTH + C_WIDTH
IN_SIZES = (A_WIDTH, A_KV_WIDTH, A_KV_WIDTH, A_WIDTH,
            B_KEY_WIDTH, B_KEY_WIDTH, B_KEY_WIDTH, B_WIDTH, B_WIDTH,
            C_WIDTH, C_WIDTH, C_WIDTH)
IN_COLS = 2 * A_WIDTH + 2 * A_KV_WIDTH + 3 * B_KEY_WIDTH + 2 * B_WIDTH + 3 * C_WIDTH
EPS = 1e-6

kernel_name = 'hybrid_diffusion_parallel_groups_step'


def rms_norm(x, g):
    xf = x.astype(jnp.float32)
    y = xf * lax.rsqrt(jnp.mean(xf * xf, axis=-1, keepdims=True) + EPS)
    return (y * g.astype(jnp.float32)).astype(x.dtype)


def layer_norm(x, g, b):
    xf = x.astype(jnp.float32)
    xc = xf - jnp.mean(xf, axis=-1, keepdims=True)
    y = xc * lax.rsqrt(jnp.mean(xc * xc, axis=-1, keepdims=True) + EPS)
    return (y * g.astype(jnp.float32) + b.astype(jnp.float32)).astype(x.dtype)


def adaln(cvec, w, b):
    m = jax.nn.silu(cvec) @ w + b
    return jnp.split(m, 3, axis=-1)


def split_proj(p):
    parts, start = [], 0
    for size in IN_SIZES:
        parts.append(p[..., start:start + size])
        start += size
    return parts


def axial_rope_tables(T):
    n_rows = T // GRID_W
    row = jnp.repeat(jnp.arange(n_rows), GRID_W).astype(jnp.float32)
    col = jnp.tile(jnp.arange(GRID_W), n_rows).astype(jnp.float32)
    half = HEAD_DIM // 2
    freq = ROPE_THETA ** (-jnp.arange(0, half, 2, dtype=jnp.float32) / half)
    ang = jnp.concatenate([row[:, None] * freq, col[:, None] * freq], axis=-1)
    return jnp.cos(ang), jnp.sin(ang)


def apply_axial_rope(x, cos, sin):
    T = x.shape[1]
    q4 = HEAD_DIM // 4
    xf = x.astype(jnp.float32).reshape(x.shape[:-1] + (2, 2, q4))
    x1 = xf[..., 0, :]
    x2 = xf[..., 1, :]
    cs = cos.reshape(T, 2, q4)[None, :, None]
    sn = sin.reshape(T, 2, q4)[None, :, None]
    out = jnp.stack([x1 * cs - x2 * sn, x2 * cs + x1 * sn], axis=-2)
    return out.reshape(x.shape).astype(x.dtype)


def sink_attend(qb, keys, vals, mask, sink):
    f32 = jnp.float32
    s = jnp.einsum('bhgqd,bhkd->bhgqk', qb.astype(f32), keys.astype(f32)) * (HEAD_DIM ** -0.5)
    if mask is not None:
        s = jnp.where(mask, s, MASK_VALUE)
    sk = sink.astype(f32).reshape(A_KV_HEADS, A_GROUP)[None, :, :, None, None]
    m = jnp.maximum(jnp.max(s, axis=-1, keepdims=True), sk)
    p = jnp.exp(s - m)
    denom = jnp.sum(p, axis=-1, keepdims=True) + jnp.exp(sk - m)
    out = jnp.einsum('bhgqk,bhkd->bhgqd', p / denom, vals.astype(f32))
    return out.astype(qb.dtype)


def query_blocks(q):
    Bn, T = q.shape[:2]
    return q.reshape(Bn, T // ATT_BLOCK, ATT_BLOCK, A_KV_HEADS, A_GROUP, HEAD_DIM).transpose(1, 0, 3, 4, 2, 5)


def merge_blocks(o, Bn, T):
    return o.transpose(1, 0, 4, 2, 3, 5).reshape(Bn, T, A_WIDTH)


def ctx_attention(q, k, v, sink):
    Bn, L = q.shape[:2]
    out = lax.map(lambda qi: sink_attend(qi, k, v, None, sink), query_blocks(q))
    return merge_blocks(out, Bn, L)


def latent_attention(q, k, v, k_ctx, v_ctx, sink):
    Bn, T = q.shape[:2]
    nblk = T // ATT_BLOCK
    Lc = k_ctx.shape[2]
    pad = ((0, 0), (0, 0), (ATT_BLOCK, ATT_BLOCK), (0, 0))
    kp = jnp.pad(k, pad)
    vp = jnp.pad(v, pad)
    q_off = jnp.arange(ATT_BLOCK)
    k_off = jnp.arange(3 * ATT_BLOCK) - ATT_BLOCK
    band = jnp.abs(k_off[None, :] - q_off[:, None]) <= WINDOW
    ctx_mask = jnp.ones((ATT_BLOCK, Lc), dtype=bool)
    k_ctx = k_ctx.astype(k.dtype)
    v_ctx = v_ctx.astype(v.dtype)

    def block(args):
        j, qi = args
        kb = lax.dynamic_slice_in_dim(kp, j * ATT_BLOCK, 3 * ATT_BLOCK, axis=2)
        vb = lax.dynamic_slice_in_dim(vp, j * ATT_BLOCK, 3 * ATT_BLOCK, axis=2)
        kpos = j * ATT_BLOCK + k_off
        valid = band & ((kpos >= 0) & (kpos < T))[None, :]
        keys = jnp.concatenate([kb, k_ctx], axis=2)
        vals = jnp.concatenate([vb, v_ctx], axis=2)
        mask = jnp.concatenate([valid, ctx_mask], axis=1)
        return sink_attend(qi, keys, vals, mask, sink)

    out = lax.map(block, (jnp.arange(nblk), query_blocks(q)))
    return merge_blocks(out, Bn, T)


def qkv_heads(aq, ak, av, qg, kg, rope):
    Bn, T = aq.shape[:2]
    q = rms_norm(aq.reshape(Bn, T, A_HEADS, HEAD_DIM), qg)
    k = rms_norm(ak.reshape(Bn, T, A_KV_HEADS, HEAD_DIM), kg)
    if rope is not None:
        q = apply_axial_rope(q, *rope)
        k = apply_axial_rope(k, *rope)
    v = av.reshape(Bn, T, A_KV_HEADS, HEAD_DIM)
    return q, k.transpose(0, 2, 1, 3), v.transpose(0, 2, 1, 3)


def hgrn_scan(q, k, v, logf, s0):
    Bn, T = q.shape[:2]
    nC = T // B_CHUNK

    def to_chunks(a):
        return a.reshape(Bn, nC, B_CHUNK, B_HEADS, a.shape[-1]).transpose(1, 0, 3, 2, 4)

    causal = jnp.tril(jnp.ones((B_CHUNK, B_CHUNK), dtype=bool))

    def step(S, xs):
        qc, kc, vc, lfc = xs
        b = jnp.cumsum(lfc, axis=-2)
        qe = qc * jnp.exp(b)
        ke = kc * jnp.exp(-b)
        att = jnp.where(causal, jnp.einsum('bhtd,bhsd->bhts', qe, ke), 0.0)
        o = jnp.einsum('bhtd,bhdv->bhtv', qe, S) + jnp.einsum('bhts,bhsv->bhtv', att, vc)
        b_last = b[..., -1:, :]
        S = jnp.exp(b_last)[..., 0, :, None] * S + jnp.einsum('bhsd,bhsv->bhdv', kc * jnp.exp(b_last - b), vc)
        return S, o

    s_end, o = lax.scan(step, s0, (to_chunks(q), to_chunks(k), to_chunks(v), to_chunks(logf)))
    o = o.transpose(1, 0, 3, 2, 4).reshape(Bn, T, B_HEADS, B_DV)
    return o, s_end


def hgrn_mixer(bq, bff, bfb, bi, bg, lb, norm_g, s0_f, s0_b):
    f32 = jnp.float32
    Bn, T = bq.shape[:2]

    def heads(a, d):
        return a.astype(f32).reshape(Bn, T, B_HEADS, d)

    q = jax.nn.silu(heads(bq, B_DK))
    v = heads(bi, B_DV)
    lbh = lb.astype(f32).reshape(2, B_HEADS, B_DK)

    def gates(z, lbd):
        logf = jax.nn.log_sigmoid(z) + jnp.log1p(lbd * jnp.exp(-z))
        return logf, (1.0 - lbd) * jax.nn.sigmoid(-z)

    lf_f, k_f = gates(heads(bff, B_DK), lbh[0])
    lf_b, k_b = gates(heads(bfb, B_DK), lbh[1])
    o_f, s_f = hgrn_scan(q, k_f, v, lf_f, s0_f.astype(f32))

    def rev(a):
        return jnp.flip(a, axis=1)

    o_b, s_b = hgrn_scan(rev(q), rev(k_b), rev(v), rev(lf_b), s0_b.astype(f32))
    o = rms_norm(o_f + rev(o_b), norm_g).reshape(Bn, T, B_WIDTH)
    return o.astype(bg.dtype) * jax.nn.silu(bg), s_f, s_b


def sgu_mixer(cu, cv, cg, ln_g, ln_b, w_s, b_s):
    Bn, T = cu.shape[:2]
    vn = layer_norm(cv, ln_g, ln_b).reshape(Bn, T // C_CHUNK, C_CHUNK, C_GROUPS, C_GROUP_DIM)
    s = jnp.einsum('gpq,bnqgc->bnpgc', w_s, vn) + jnp.transpose(b_s)[None, None, :, :, None]
    return cu * s.reshape(Bn, T, C_WIDTH) * jax.nn.silu(cg)


def layer_step(x, cvec, p, rope, attend, s0_f, s0_b):
    norm_g, w_ada, b_ada, w_in, qg, kg, lb, hg, lng, lnb, ws, bs, w_out = p
    shift, scale, gate = adaln(cvec, w_ada, b_ada)
    h = rms_norm(x, norm_g) * (1.0 + scale) + shift
    aq, ak, av, ag, bq, bff, bfb, bi, bg, cu, cv, cg = split_proj(h @ w_in)
    q, k, v = qkv_heads(aq, ak, av, qg, kg, rope)
    a_out = attend(q, k, v) * jax.nn.silu(ag)
    b_out, s_f, s_b = hgrn_mixer(bq, bff, bfb, bi, bg, lb, hg, s0_f, s0_b)
    c_out = sgu_mixer(cu, cv, cg, lng, lnb, ws, bs)
    y = jnp.concatenate([a_out, b_out, c_out], axis=-1) @ w_out
    return x + gate * y, k, v, s_f, s_b


def setup_inputs(seed: int = 0) -> dict:
    key = jax.random.key(seed)
    ks = jax.random.split(key, 21)

    def n(k, s):
        return jax.random.normal(k, s, jnp.float32)

    return {
        'x_prompt': n(ks[0], (BATCH, SEQ, D_MODEL)),
        'x_sample': n(ks[1], (DEC_BATCH, DEC_SEQ, D_MODEL)),
        'cache_k': n(ks[2], (DEC_BATCH, DEPTH, A_KV_HEADS, PAST_LEN, HEAD_DIM)),
        'cache_v': n(ks[3], (DEC_BATCH, DEPTH, A_KV_HEADS, PAST_LEN, HEAD_DIM)),
        'state_hgrn': 0.3 * n(ks[4], (DEC_BATCH, DEPTH, 2, B_HEADS, B_DK, B_DV)),
        'c': n(ks[5], (DEC_BATCH, D_MODEL)),
        'c_ctx': n(ks[6], (D_MODEL,)),
        'norm_g': 1.0 + 0.05 * n(ks[7], (DEPTH, D_MODEL)),
        'w_ada': (0.2 * D_MODEL ** -0.5) * n(ks[8], (DEPTH, D_MODEL, 3 * D_MODEL)),
        'b_ada': 0.02 * n(ks[9], (DEPTH, 3 * D_MODEL)),
        'w_in': (D_MODEL ** -0.5) * n(ks[10], (DEPTH, D_MODEL, IN_COLS)),
        'q_norm_g': 1.0 + 0.05 * n(ks[11], (DEPTH, HEAD_DIM)),
        'k_norm_g': 1.0 + 0.05 * n(ks[12], (DEPTH, HEAD_DIM)),
        'attn_sink': 0.5 * n(ks[13], (DEPTH, A_HEADS)),
        'hgrn_lb': n(ks[14], (DEPTH, 2, B_KEY_WIDTH)),
        'hgrn_norm_g': 1.0 + 0.05 * n(ks[15], (DEPTH, B_DV)),
        'sgu_norm_g': 1.0 + 0.05 * n(ks[16], (DEPTH, C_WIDTH)),
        'sgu_norm_b': 0.02 * n(ks[17], (DEPTH, C_WIDTH)),
        'sgu_w': (C_CHUNK ** -0.5) * n(ks[18], (DEPTH, C_GROUPS, C_CHUNK, C_CHUNK)),
        'sgu_b': 1.0 + 0.05 * n(ks[19], (DEPTH, C_GROUPS, C_CHUNK)),
        'w_out': (MIX_WIDTH ** -0.5) * n(ks[20], (DEPTH, MIX_WIDTH, D_MODEL)),
    }


def reference(x_prompt, x_sample, cache_k, cache_v, state_hgrn, c, c_ctx, norm_g, w_ada, b_ada, w_in,
              q_norm_g, k_norm_g, attn_sink, hgrn_lb, hgrn_norm_g, sgu_norm_g, sgu_norm_b, sgu_w, sgu_b, w_out):
    lb_p = jax.nn.softmax(hgrn_lb.astype(jnp.float32), axis=0)
    lb_all = jnp.cumsum(lb_p, axis=0) - lb_p[0:1]
    rope = axial_rope_tables(x_sample.shape[1])
    ctx_cond = c_ctx[None, None, :]
    lat_cond = c[:, None, :]
    s_zero = jnp.zeros((x_prompt.shape[0], B_HEADS, B_DK, B_DV), jnp.float32)
    xp = x_prompt
    xs = x_sample
    ks_out, vs_out, ss_out = [], [], []
    for l in range(DEPTH):
        p = (norm_g[l], w_ada[l], b_ada[l], w_in[l], q_norm_g[l], k_norm_g[l], lb_all[l], hgrn_norm_g[l],
             sgu_norm_g[l], sgu_norm_b[l], sgu_w[l], sgu_b[l], w_out[l])
        sink = attn_sink[l]
        xp, k_c, v_c, sf_c, sb_c = layer_step(
            xp, ctx_cond, p, None, lambda q, k, v: ctx_attention(q, k, v, sink), s_zero, s_zero)
        ks_out.append(k_c)
        vs_out.append(v_c)
        ss_out.append(jnp.stack([sf_c, sb_c], axis=1).astype(xp.dtype))
        kc_l = cache_k[:, l]
        vc_l = cache_v[:, l]
        xs, _, _, _, _ = layer_step(
            xs, lat_cond, p, rope,
            lambda q, k, v: latent_attention(q, k, v, kc_l, vc_l, sink),
            state_hgrn[:, l, 0], state_hgrn[:, l, 1])
    y_prompt = xp
    y_sample = xs
    new_cache_k = jnp.stack(ks_out, axis=1)
    new_cache_v = jnp.stack(vs_out, axis=1)
    new_state_hgrn = jnp.stack(ss_out, axis=1)
    return (y_prompt, y_sample, new_cache_k, new_cache_v, new_state_hgrn)
```

```cpp
#include <hip/hip_runtime.h>
#include <hip/hip_cooperative_groups.h>
#include <cstdio>
#include <cstdint>
namespace cg = cooperative_groups;
namespace pg8 {
#define PG8_LAS __attribute__((address_space(3)))
typedef unsigned short bf16_t;
typedef short bf16x8 __attribute__((ext_vector_type(8)));
typedef float f32x4 __attribute__((ext_vector_type(4)));
typedef unsigned u32x4 __attribute__((ext_vector_type(4)));
constexpr int BM = 256, BK = 64, HALF = 128, HTB = HALF * BK * 2  , STAGE_BYTES = 8 * HTB, NXCD = 8, WGM = 4;

__host__ __device__ __forceinline__ int lds_byte(int r, int c) { const int st = (r >> 4) * 2 + (c >> 5), rr = r & 15, cc = c & 31, ob = rr * 64 + cc * 2; return st * 1024 + (ob ^ (((ob >> 9) & 1) << 5)); }
__host__ __device__ __forceinline__ void stage_rc(int b, int& R, int& C) { const int st = b / 1024, sb = b % 1024, swz = sb ^ (((sb >> 9) & 1) << 5); R = (st >> 1) * 16 + swz / 64; C = (st & 1) * 32 + (swz % 64) / 2; }
__host__ __device__ __forceinline__ int perm32(int rho) { const int n = rho >> 4, i = rho & 15; return 8 * (i >> 2) + 4 * n + (i & 3); }

struct Unit { int pm, pn; };
struct Gemm { const bf16_t* A; const bf16_t* Bt; int M, N, K; };

struct StaticOrder {
    int nM, nN, nwg, G, c;
    __host__ __device__ void init(int M, int N, int G_, int c_) { nM = M / BM; nN = N / BM; nwg = nM * nN; G = G_; c = c_; }
    __host__ __device__ bool next(int i, Unit& u) const {
        const long L = (long)i * G + c; if (L >= nwg) return false;
        int wgid = (int)L; { const int q = nwg / NXCD, r = nwg % NXCD, xcd = wgid % NXCD, off = wgid / NXCD; wgid = (xcd < r ? xcd * (q + 1) : r * (q + 1) + (xcd - r) * q) + off; }
        const int nig = WGM * nN, gid = wgid / nig, fm = gid * WGM, gsz = (nM - fm) < WGM ? (nM - fm) : WGM;
        u.pm = fm + ((wgid % nig) % gsz); u.pn = (wgid % nig) / gsz; return true;
    }
    __device__ __forceinline__ void a_ready(const Unit&) const {}
    __device__ __forceinline__ void done(const Unit&) const {}
};

__device__ __forceinline__ unsigned cvt_pk_bf16(float lo, float hi) { unsigned r; asm volatile("v_cvt_pk_bf16_f32 %0, %1, %2" : "=v"(r) : "v"(lo), "v"(hi)); return r; }
typedef float f32x2 __attribute__((ext_vector_type(2)));
__device__ __forceinline__ f32x2 gelu_pk(f32x2 v) {
    const f32x2 av = __builtin_elementwise_abs(v), d = av * 0.2316418882f + 1.0f;
    f32x2 t; t.x = __builtin_amdgcn_rcpf(d.x); t.y = __builtin_amdgcn_rcpf(d.y);
    f32x2 q = t * 0.5307027145f + (-0.7265760135f); q = q * t + 0.7107068705f; q = q * t + (-0.142248368f); q = q * t + 0.127414796f; q = q * t;
    const f32x2 s = (v * v) * (-0.72134752044f);
    f32x2 e; e.x = __builtin_amdgcn_exp2f(s.x); e.y = __builtin_amdgcn_exp2f(s.y);
    const f32x2 m = v * (q * e), r = v - m;
    f32x2 o; o.x = v.x < 0.f ? m.x : r.x; o.y = v.y < 0.f ? m.y : r.y; return o;
}

template <int ACT  > struct EpiBf16 {
    static constexpr bool PERM = true, AFTER_DRAIN = false; static_assert(ACT == 0 || ACT == 1, "EpiBf16: ACT is 0 (none) or 1 (gelu_pk)");
    bf16_t* O; int ldc; const float* bias; int split_cols; size_t split_stride; float scale0;
    __device__ __forceinline__ void operator()(const f32x4 (&acc)[2][2][4][2], const Unit& u, int wr, int wc, int fr, int fq) const {
        const int row0 = u.pm * BM + wr * 64 + fr; int colt = u.pn * BM; bf16_t* base = O;
        float sc = 1.f; if (split_cols) { const int t = colt / split_cols; base += (size_t)t * split_stride; colt -= t * split_cols; if (t == 0) sc = scale0; }
        const int col0 = colt + wc * 32 + 8 * fq, bcol0 = u.pn * BM + wc * 32 + 8 * fq;
        f32x4 bv[2][2];
#pragma unroll
        for (int bj = 0; bj < 2; ++bj)
#pragma unroll
            for (int n = 0; n < 2; ++n) bv[bj][n] = bias ? *(const f32x4*)(bias + bcol0 + bj * HALF + 4 * n) : (f32x4){0.f, 0.f, 0.f, 0.f};
#pragma unroll
        for (int ai = 0; ai < 2; ++ai)
#pragma unroll
            for (int m = 0; m < 4; ++m) { bf16_t* rowp = base + (size_t)(row0 + ai * HALF + m * 16) * ldc + col0;
#pragma unroll
                for (int bj = 0; bj < 2; ++bj) { f32x4 v0 = acc[ai][bj][m][0] + bv[bj][0], v1 = acc[ai][bj][m][1] + bv[bj][1];
                    if (ACT == 1) { f32x2 a = gelu_pk((f32x2){v0[0], v0[1]}), b = gelu_pk((f32x2){v0[2], v0[3]}), c = gelu_pk((f32x2){v1[0], v1[1]}), d = gelu_pk((f32x2){v1[2], v1[3]});
                        v0 = (f32x4){a.x, a.y, b.x, b.y}; v1 = (f32x4){c.x, c.y, d.x, d.y}; }
                    v0 = v0 * sc; v1 = v1 * sc; u32x4 w; w.x = cvt_pk_bf16(v0[0], v0[1]); w.y = cvt_pk_bf16(v0[2], v0[3]); w.z = cvt_pk_bf16(v1[0], v1[1]); w.w = cvt_pk_bf16(v1[2], v1[3]);
                    *(u32x4*)(rowp + bj * HALF) = w; } }
    }
};

template <class Epi, class Sched, bool ALIGN_EPI = false, bool SP2 = false>
__device__ __forceinline__ void gemm_phase(PG8_LAS unsigned char* lds, const Gemm g, const Sched& S, const Epi& E) {
    int tid_ = threadIdx.x; asm volatile("" : "+v"(tid_)); const int tid = tid_, wid = __builtin_amdgcn_readfirstlane(tid >> 6), lane = tid & 63, wr = wid >> 2, wc = wid & 3, fr = lane & 15, fq = lane >> 4;
    const int K = g.K, nt = K / BK;
    unsigned voffA[2], voffB[2];
#pragma unroll
    for (int i = 0; i < 2; ++i) { int R, C; stage_rc(tid * 16 + i * 8192, R, C); const int Rb = Epi::PERM ? ((R & ~31) + perm32(R & 31)) : R;
        voffA[i] = (unsigned)(R * K + C) * 2u; voffB[i] = (unsigned)(Rb * K + C) * 2u; }
    const size_t kstep = (size_t)(BK * 2);
    const size_t hstep = (size_t)HALF * K * 2;
    const size_t tstep = 2 * hstep;
    const unsigned ldsw = (unsigned)wid * 1024u;
    const int aoff = lds_byte(wr * 64 + fr, fq * 8), boff = lds_byte(wc * 32 + fr, fq * 8);
#define PG8_SA(b, h) (((b) * 2 + (h)) * HTB)
#define PG8_SB(b, h) ((4 + (b) * 2 + (h)) * HTB)
#define PG8_STAGE(bufoff, gbase, voff) do { _Pragma("unroll") for (int _i = 0; _i < 2; ++_i) \
        __builtin_amdgcn_global_load_lds((const unsigned*)((const char*)(gbase) + (voff)[_i]), (PG8_LAS unsigned*)(lds + (bufoff) + ldsw + _i * 8192), 16, 0, 0); } while (0)
#define PG8_LDA(dst, b, h) do { _Pragma("unroll") for (int m = 0; m < 4; ++m) _Pragma("unroll") for (int k = 0; k < 2; ++k) dst[m][k] = *(const PG8_LAS bf16x8*)(lds + PG8_SA(b, h) + aoff + m * 2048 + k * 1024); } while (0)
#define PG8_LDB(dst, b, h) do { _Pragma("unroll") for (int n = 0; n < 2; ++n) _Pragma("unroll") for (int k = 0; k < 2; ++k) dst[n][k] = *(const PG8_LAS bf16x8*)(lds + PG8_SB(b, h) + boff + n * 2048 + k * 1024); } while (0)
#define PG8_MMA(ai, bj, At, Bt) do { __builtin_amdgcn_s_setprio(1); _Pragma("unroll") for (int m = 0; m < 4; ++m) _Pragma("unroll") for (int n = 0; n < 2; ++n) _Pragma("unroll") for (int k = 0; k < 2; ++k) \
        acc[ai][bj][m][n] = __builtin_amdgcn_mfma_f32_16x16x32_bf16(Bt[n][k], At[m][k], acc[ai][bj][m][n], 0, 0, 0); __builtin_amdgcn_s_setprio(0); } while (0)
#define PG8_WAIT_V(n) asm volatile("s_waitcnt vmcnt(" #n ")" ::: "memory")
#define PG8_WAIT_L(n) asm volatile("s_waitcnt lgkmcnt(" #n ")" ::: "memory")
#define PG8_BAR __builtin_amdgcn_s_barrier()
#define PG8_SCHED __builtin_amdgcn_sched_barrier(0)
    Unit cur, nxt; int ui = 0;
    if (!S.next(0, cur)) return;
    f32x4 acc[2][2][4][2];
#pragma unroll
    for (int a = 0; a < 2; ++a)
#pragma unroll
        for (int b = 0; b < 2; ++b)
#pragma unroll
            for (int m = 0; m < 4; ++m)
#pragma unroll
                for (int n = 0; n < 2; ++n) acc[a][b][m][n] = (f32x4){0.f, 0.f, 0.f, 0.f};
    bf16x8 At[4][2], B0[2][2], B1[2][2];
    const char* cA = (const char*)g.A + (size_t)cur.pm * tstep; const char* cB = (const char*)g.Bt + (size_t)cur.pn * tstep;
    S.a_ready(cur);
    if constexpr (SP2) {
        PG8_STAGE(PG8_SB(0, 0), cB, voffB); PG8_STAGE(PG8_SB(0, 1), cB + hstep, voffB); PG8_STAGE(PG8_SA(0, 0), cA, voffA); PG8_STAGE(PG8_SA(0, 1), cA + hstep, voffA);
        if (wr == 1) PG8_BAR;
        PG8_WAIT_V(2); PG8_BAR;
        PG8_STAGE(PG8_SB(1, 0), cB + kstep, voffB); PG8_STAGE(PG8_SA(1, 0), cA + kstep, voffA); PG8_STAGE(PG8_SB(1, 1), cB + hstep + kstep, voffB);
        PG8_WAIT_V(6); PG8_BAR;
    } else {
        PG8_STAGE(PG8_SB(0, 0), cB, voffB); PG8_STAGE(PG8_SA(0, 0), cA, voffA); PG8_STAGE(PG8_SB(0, 1), cB + hstep, voffB); PG8_STAGE(PG8_SA(0, 1), cA + hstep, voffA);
        if (wr == 1) PG8_BAR;
        PG8_WAIT_V(4); PG8_BAR;
        PG8_STAGE(PG8_SB(1, 0), cB + kstep, voffB); PG8_STAGE(PG8_SA(1, 0), cA + kstep, voffA); PG8_STAGE(PG8_SB(1, 1), cB + hstep + kstep, voffB);
        PG8_WAIT_V(6); PG8_BAR;
    }
    for (;;) {
        const bool has_next = S.next(ui + 1, nxt);
        const char* nA = has_next ? (const char*)g.A + (size_t)nxt.pm * tstep : cA; const char* nB = has_next ? (const char*)g.Bt + (size_t)nxt.pn * tstep : cB;
        for (int t = 0; t < nt; t += 2) {
            const bool last = (t == nt - 2);
            const char* a1 = cA + (size_t)(t + 1) * kstep;
            const char* a2 = last ? nA : cA + (size_t)(t + 2) * kstep; const char* b2 = last ? nB : cB + (size_t)(t + 2) * kstep;
            const char* a3 = a2 + kstep; const char* b3 = b2 + kstep;
            if (last && has_next) S.a_ready(nxt);
            if constexpr (SP2) {
            PG8_LDB(B0, 0, 0); PG8_LDB(B1, 0, 1); PG8_SCHED; PG8_LDA(At, 0, 0); PG8_STAGE(PG8_SA(1, 1), a1 + hstep, voffA);
            PG8_WAIT_V(8); PG8_WAIT_L(0); PG8_BAR; PG8_MMA(0, 0, At, B0); PG8_MMA(0, 1, At, B1); PG8_BAR; PG8_SCHED;
            PG8_LDA(At, 0, 1); PG8_STAGE(PG8_SB(0, 0), b2, voffB); PG8_STAGE(PG8_SB(0, 1), b2 + hstep, voffB); PG8_STAGE(PG8_SA(0, 0), a2, voffA);
            PG8_WAIT_V(8); PG8_WAIT_L(0); PG8_BAR; PG8_MMA(1, 0, At, B0); PG8_MMA(1, 1, At, B1); PG8_BAR; PG8_SCHED;
            PG8_LDB(B0, 1, 0); PG8_LDB(B1, 1, 1); PG8_SCHED; PG8_LDA(At, 1, 0); PG8_STAGE(PG8_SA(0, 1), a2 + hstep, voffA);
            PG8_WAIT_V(8); PG8_WAIT_L(0); PG8_BAR; PG8_MMA(0, 0, At, B0); PG8_MMA(0, 1, At, B1); PG8_BAR; PG8_SCHED;
            PG8_LDA(At, 1, 1); PG8_STAGE(PG8_SB(1, 0), b3, voffB); PG8_STAGE(PG8_SB(1, 1), b3 + hstep, voffB); PG8_STAGE(PG8_SA(1, 0), a3, voffA);
            PG8_WAIT_V(8); PG8_WAIT_L(0); PG8_BAR; PG8_MMA(1, 0, At, B0); PG8_MMA(1, 1, At, B1); PG8_BAR; PG8_SCHED;
            } else {
            PG8_LDB(B0, 0, 0); PG8_SCHED; PG8_LDA(At, 0, 0); PG8_STAGE(PG8_SA(1, 1), a1 + hstep, voffA);
            PG8_WAIT_L(8); PG8_BAR; PG8_WAIT_L(0); PG8_MMA(0, 0, At, B0); PG8_BAR; PG8_SCHED;
            PG8_LDB(B1, 0, 1); PG8_STAGE(PG8_SB(0, 0), b2, voffB);
            PG8_BAR; PG8_WAIT_L(0); PG8_MMA(0, 1, At, B1); PG8_BAR;
            PG8_LDA(At, 0, 1); PG8_STAGE(PG8_SA(0, 0), a2, voffA);
            PG8_BAR; PG8_WAIT_L(0); PG8_MMA(1, 0, At, B0); PG8_BAR; PG8_SCHED;
            PG8_STAGE(PG8_SB(0, 1), b2 + hstep, voffB);
            PG8_WAIT_V(6); PG8_BAR; PG8_MMA(1, 1, At, B1); PG8_BAR;
            PG8_LDB(B0, 1, 0); PG8_SCHED; PG8_LDA(At, 1, 0); PG8_STAGE(PG8_SA(0, 1), a2 + hstep, voffA);
            PG8_WAIT_L(8); PG8_BAR; PG8_WAIT_L(0); PG8_MMA(0, 0, At, B0); PG8_BAR; PG8_SCHED;
            PG8_LDB(B1, 1, 1); PG8_STAGE(PG8_SB(1, 0), b3, voffB);
            PG8_BAR; PG8_WAIT_L(0); PG8_MMA(0, 1, At, B1); PG8_BAR;
            PG8_LDA(At, 1, 1); PG8_STAGE(PG8_SA(1, 0), a3, voffA);
            PG8_BAR; PG8_WAIT_L(0); PG8_MMA(1, 0, At, B0); PG8_BAR; PG8_SCHED;
            PG8_STAGE(PG8_SB(1, 1), b3 + hstep, voffB);
            PG8_WAIT_V(6); PG8_BAR; PG8_MMA(1, 1, At, B1); PG8_BAR;
            }
        }
        if constexpr (ALIGN_EPI) { if (wr == 0) PG8_BAR; }
        if constexpr (!Epi::AFTER_DRAIN) { E(acc, cur, wr, wc, fr, fq); S.done(cur); }
        if (!has_next) break;
#pragma unroll
        for (int a = 0; a < 2; ++a)
#pragma unroll
            for (int b = 0; b < 2; ++b)
#pragma unroll
                for (int m = 0; m < 4; ++m)
#pragma unroll
                    for (int n = 0; n < 2; ++n) acc[a][b][m][n] = (f32x4){0.f, 0.f, 0.f, 0.f};
        cur = nxt; cA = nA; cB = nB; ++ui;
        if constexpr (ALIGN_EPI) { if (wr == 1) PG8_BAR; }
    }
    PG8_WAIT_V(0);
    if constexpr (!ALIGN_EPI) { if (wr == 0) PG8_BAR; }
    PG8_BAR;
    if constexpr (Epi::AFTER_DRAIN) { E.fused(acc, cur, wr, wc, fr, fq, lds, wid, lane); S.done(cur); }
#undef PG8_SA
#undef PG8_SB
#undef PG8_STAGE
#undef PG8_LDA
#undef PG8_LDB
#undef PG8_MMA
#undef PG8_WAIT_V
#undef PG8_WAIT_L
#undef PG8_BAR
#undef PG8_SCHED
}
}

typedef unsigned short bf16;
typedef float f32x4 __attribute__((ext_vector_type(4)));
typedef short bf16x8 __attribute__((ext_vector_type(8)));
typedef short bf16x4 __attribute__((ext_vector_type(4)));
typedef unsigned u32x4 __attribute__((ext_vector_type(4)));
typedef unsigned u32x2 __attribute__((ext_vector_type(2)));
typedef float f32x2_t __attribute__((ext_vector_type(2)));
typedef __bf16 bf16x2_t __attribute__((ext_vector_type(2)));

constexpr int DM = 2048, NCTX_ROWS = 4096, M_ROWS = 36864, NP = 6656, NMOD = 6144;
constexpr int C_AQ = 0, C_AK = 1024, C_AV = 1280, C_AG = 1536, C_BQ = 2560, C_BFF = 3072, C_BFB = 3584, C_BI = 4096, C_BG = 4608, C_CU = 5120, C_CV = 5632, C_CG = 6144;
constexpr size_t MiB = 1u << 20;
constexpr size_t WS_CTL = 0, WS_ROPE = 4096, WS_MOD = 32768, WS_WIN = 1 * MiB, WS_WOUT = 53 * MiB, WS_H = 70 * MiB, WS_P = 214 * MiB, WS_O = 682 * MiB, WS_SLOC = 826 * MiB, WS_DLOG = 858 * MiB, WS_KC = 859 * MiB, WS_VCT = 863 * MiB, WS_END = 867 * MiB;
constexpr size_t OUT_Y = 0, OUT_K = 75497472, OUT_V = 77594624, OUT_S = 79691776;
constexpr int LDS_BYTES = 147456, LDS_BCAST = 147456 - 64;
constexpr float EPSN = 1e-6f, LOG2E = 1.4426950408889634f;
constexpr int N_HL = 256, N_AL = 1024, N_AC = 128, N_HC = 64, N_SG = 288;

struct Prm {
    const float *x_prompt, *x_sample, *cache_k, *cache_v, *state, *c, *c_ctx, *norm_g, *w_ada, *b_ada, *w_in, *qg, *kg, *sink, *hlb, *hg, *lng, *lnb, *sgw, *sgb, *w_out;
    float* out; unsigned char* ws;
};

__device__ __forceinline__ float bf2f(unsigned u) { return __builtin_bit_cast(float, u << 16); }
__device__ __forceinline__ unsigned cvtpk(float lo, float hi) { f32x2_t v = {lo, hi}; bf16x2_t b = __builtin_convertvector(v, bf16x2_t); return __builtin_bit_cast(unsigned, b); }
__device__ __forceinline__ unsigned short f2bf1(float f) { return (unsigned short)(cvtpk(f, 0.f) & 0xffffu); }
__device__ __forceinline__ void unpack8(u32x4 v, float* o) {
    o[0] = bf2f(v.x & 0xffffu); o[1] = __builtin_bit_cast(float, v.x & 0xffff0000u); o[2] = bf2f(v.y & 0xffffu); o[3] = __builtin_bit_cast(float, v.y & 0xffff0000u);
    o[4] = bf2f(v.z & 0xffffu); o[5] = __builtin_bit_cast(float, v.z & 0xffff0000u); o[6] = bf2f(v.w & 0xffffu); o[7] = __builtin_bit_cast(float, v.w & 0xffff0000u);
}
__device__ __forceinline__ u32x4 pack8(const float* x) { u32x4 r; r.x = cvtpk(x[0], x[1]); r.y = cvtpk(x[2], x[3]); r.z = cvtpk(x[4], x[5]); r.w = cvtpk(x[6], x[7]); return r; }
__device__ __forceinline__ bf16x8 pack8f(f32x4 a, f32x4 b) { u32x4 r; r.x = cvtpk(a[0], a[1]); r.y = cvtpk(a[2], a[3]); r.z = cvtpk(b[0], b[1]); r.w = cvtpk(b[2], b[3]); return __builtin_bit_cast(bf16x8, r); }
__device__ __forceinline__ bf16x8 ld_perm(const bf16* p) {
    u32x2 a = *(const u32x2*)p, b = *(const u32x2*)(p + 16); u32x4 r; r.x = a.x; r.y = a.y; r.z = b.x; r.w = b.y; return __builtin_bit_cast(bf16x8, r);
}
__device__ __forceinline__ int perm32(int k) { return ((k & 12) << 1) + (k & 3) + ((k & 16) >> 2); }
__device__ __forceinline__ float silu_f(float x) { return x * __builtin_amdgcn_rcpf(1.f + __expf(-x)); }
template <int M> __device__ __forceinline__ float shx(float v, int lane) {
    if constexpr (M < 32) return __builtin_bit_cast(float, __builtin_amdgcn_ds_swizzle(__builtin_bit_cast(int, v), (M << 10) | 0x1f));
    else return __builtin_bit_cast(float, __builtin_amdgcn_ds_bpermute((lane ^ 32) << 2, __builtin_bit_cast(int, v)));
}
__device__ __forceinline__ f32x4 mfma16(bf16x8 a, bf16x8 b, f32x4 c) { return __builtin_amdgcn_mfma_f32_16x16x32_bf16(a, b, c, 0, 0, 0); }
__device__ __forceinline__ const float* xrow_ptr(const float* xp, const float* xs, int m) { return m < NCTX_ROWS ? xp + (size_t)m * DM : xs + (size_t)(m - NCTX_ROWS) * DM; }
__device__ __forceinline__ int mod_index(int m) { return m < NCTX_ROWS ? 0 : 1 + ((m - NCTX_ROWS) >> 12); }

__device__ __forceinline__ void transpose_item(const float* W, int K, int N, bf16* WT, float* scr, int item, int lane) {
    const int nblk = N / 32, kb = item / nblk, nb = item % nblk, k0 = 64 * kb, n0 = 32 * nb;
    float tv[32];
#pragma unroll
    for (int i = 0; i < 32; ++i) tv[i] = W[(size_t)(k0 + 2 * i + (lane >> 5)) * N + n0 + (lane & 31)];
#pragma unroll
    for (int i = 0; i < 32; ++i) scr[(2 * i + (lane >> 5)) * 33 + (lane & 31)] = tv[i];
    __builtin_amdgcn_s_waitcnt(0); __builtin_amdgcn_wave_barrier();
    const int c = lane & 7;
#pragma unroll
    for (int j = 0; j < 4; ++j) { const int n = (lane >> 3) + 8 * j; const float* s = scr + (8 * c) * 33 + n;
        u32x4 o; o.x = cvtpk(s[0 * 33], s[1 * 33]); o.y = cvtpk(s[2 * 33], s[3 * 33]); o.z = cvtpk(s[4 * 33], s[5 * 33]); o.w = cvtpk(s[6 * 33], s[7 * 33]);
        *(u32x4*)(WT + (size_t)(n0 + n) * K + k0 + 8 * c) = o; }
    __builtin_amdgcn_s_waitcnt(0); __builtin_amdgcn_wave_barrier();
}

__device__ __forceinline__ void phase0(const Prm& p, unsigned char* lds) {
    int tid_ = threadIdx.x; asm volatile("" : "+v"(tid_)); const int tid = tid_, lane = tid & 63, w = tid >> 6, G = gridDim.x;
    float* mod = (float*)(p.ws + WS_MOD);
    for (int g = blockIdx.x; g < 192; g += G) {
        float* sc = (float*)lds; float* red = (float*)(lds + 73728);
        __syncthreads();
        for (int e = tid; e < 9 * 2048; e += 512) { const int j = e >> 11, k = e & 2047; const float v = j == 0 ? p.c_ctx[k] : p.c[(j - 1) * 2048 + k]; sc[e] = silu_f(v); }
        __syncthreads();
        const int l = g / 96, cgp = g % 96, col = cgp * 64 + lane;
        float acc[9];
#pragma unroll
        for (int j = 0; j < 9; ++j) acc[j] = 0.f;
        const float* wp = p.w_ada + (size_t)l * 2048 * NMOD + (size_t)(w * 256) * NMOD + col;
#pragma unroll 32
        for (int k = 0; k < 256; ++k) { const float wv = wp[(size_t)k * NMOD];
#pragma unroll
            for (int j = 0; j < 9; ++j) acc[j] += sc[j * 2048 + w * 256 + k] * wv; }
#pragma unroll
        for (int j = 0; j < 9; ++j) red[(w * 9 + j) * 64 + lane] = acc[j];
        __syncthreads();
        for (int e = tid; e < 576; e += 512) { const int j = e >> 6, ln = e & 63; float s = 0.f;
#pragma unroll
            for (int ww = 0; ww < 8; ++ww) s += red[(ww * 9 + j) * 64 + ln];
            mod[(l * 9 + j) * NMOD + cgp * 64 + ln] = s + p.b_ada[l * NMOD + cgp * 64 + ln]; }
    }
    __syncthreads();
    {   bf16* Kc = (bf16*)(p.ws + WS_KC); bf16* Vct = (bf16*)(p.ws + WS_VCT);
        for (int u = blockIdx.x * 512 + tid; u < 262144; u += G * 512) {
            const f32x4 a = *(const f32x4*)(p.cache_k + (size_t)u * 8), bq = *(const f32x4*)(p.cache_k + (size_t)u * 8 + 4);
            u32x4 o; o.x = cvtpk(a.x, a.y); o.y = cvtpk(a.z, a.w); o.z = cvtpk(bq.x, bq.y); o.w = cvtpk(bq.z, bq.w); *(u32x4*)(Kc + (size_t)u * 8) = o;
            const int dd = u & 127, kg8 = (u >> 7) & 7, blk = u >> 10; const float* vs = p.cache_v + (size_t)blk * 8192 + (size_t)(kg8 * 8) * 128 + dd;
            float v[8];
#pragma unroll
            for (int i = 0; i < 8; ++i) v[i] = vs[i * 128];
            const u32x4 pk = pack8(v); bf16* vrow = Vct + (size_t)blk * 8192 + dd * 64 + ((kg8 * 8) & 32);
            u32x2 lo2, hi2; lo2.x = pk.x; lo2.y = pk.y; hi2.x = pk.z; hi2.y = pk.w;
            *(u32x2*)(vrow + perm32((kg8 * 8) & 31)) = lo2; *(u32x2*)(vrow + perm32(((kg8 * 8) & 31) + 4)) = hi2; }
    }
    float* scr = (float*)(lds + w * 16384);
    const int gw = blockIdx.x * 8 + w, NGW = G * 8;
    constexpr int I_IN = 32 * 208, I_OUT = 32 * 64, NIT = 2 * (I_IN + I_OUT);
    for (int it = gw; it < NIT; it += NGW) {
        int r = it;
        if (r < 2 * I_IN) { const int l = r / I_IN; r -= l * I_IN; transpose_item(p.w_in + (size_t)l * 2048 * NP, 2048, NP, (bf16*)(p.ws + WS_WIN) + (size_t)l * NP * 2048, scr, r, lane); }
        else { r -= 2 * I_IN; const int l = r / I_OUT; r -= l * I_OUT; transpose_item(p.w_out + (size_t)l * 2048 * 2048, 2048, 2048, (bf16*)(p.ws + WS_WOUT) + (size_t)l * 2048 * 2048, scr, r, lane); }
    }
}

__device__ __forceinline__ void phase_norm(const Prm& p, int l, const float* xp, const float* xs) {
    int tid_ = threadIdx.x; asm volatile("" : "+v"(tid_)); const int tid = tid_, lane = tid & 63, w = tid >> 6;
    const int gw = blockIdx.x * 8 + w, NGW = gridDim.x * 8, RPW = (M_ROWS + NGW - 1) / NGW;
    const float* mod = (const float*)(p.ws + WS_MOD) + (size_t)l * 9 * NMOD;
    bf16* H = (bf16*)(p.ws + WS_H);
    f32x4 A[8], B[8]; int curj = -1;
    const int m1 = min(M_ROWS, (gw + 1) * RPW);
    f32x4 v[8], vn[8];
    int m = gw * RPW;
    if (m < m1) { const f32x4* xr = (const f32x4*)xrow_ptr(xp, xs, m) + lane;
#pragma unroll
        for (int i = 0; i < 8; ++i) v[i] = __builtin_nontemporal_load(xr + 64 * i); }
    for (; m < m1; ++m) {
        const int j = mod_index(m);
        if (j != curj) { curj = j;
#pragma unroll
            for (int i = 0; i < 8; ++i) { const int c = 4 * (lane + 64 * i); const f32x4 g = *(const f32x4*)(p.norm_g + l * DM + c); const f32x4 sh = *(const f32x4*)(mod + j * NMOD + c), scl = *(const f32x4*)(mod + j * NMOD + 2048 + c);
                A[i] = g * (scl + 1.f); B[i] = sh; } }
        if (m + 1 < m1) { const f32x4* xr = (const f32x4*)xrow_ptr(xp, xs, m + 1) + lane;
#pragma unroll
            for (int i = 0; i < 8; ++i) vn[i] = __builtin_nontemporal_load(xr + 64 * i); }
        float ss = 0.f;
#pragma unroll
        for (int i = 0; i < 8; ++i) ss += (v[i].x * v[i].x + v[i].y * v[i].y) + (v[i].z * v[i].z + v[i].w * v[i].w);
        ss += shx<1>(ss, lane); ss += shx<2>(ss, lane); ss += shx<4>(ss, lane); ss += shx<8>(ss, lane); ss += shx<16>(ss, lane); ss += shx<32>(ss, lane);
        const float rstd = rsqrtf(ss * (1.f / DM) + EPSN);
        u32x2* o8 = (u32x2*)(H + (size_t)m * DM) + lane;
#pragma unroll
        for (int i = 0; i < 8; ++i) { const f32x4 y = v[i] * rstd * A[i] + B[i]; u32x2 o; o.x = cvtpk(y.x, y.y); o.y = cvtpk(y.z, y.w); o8[64 * i] = o; }
#pragma unroll
        for (int i = 0; i < 8; ++i) v[i] = vn[i];
    }
}

struct EpiResid {
    static constexpr bool PERM = true, AFTER_DRAIN = false;
    const float* xp; const float* xs; float* out; const float* mod;
    __device__ __forceinline__ void operator()(const pg8::f32x4 (&acc)[2][2][4][2], const pg8::Unit& u, int wr, int wc, int fr, int fq) const {
        const int j = u.pm < 16 ? 0 : 1 + ((u.pm - 16) >> 4);
        const float* gate = mod + j * NMOD + 4096;
        const int col0 = u.pn * 256 + wc * 32 + 8 * fq;
        f32x4 gv[2][2];
#pragma unroll
        for (int bj = 0; bj < 2; ++bj)
#pragma unroll
            for (int n = 0; n < 2; ++n) gv[bj][n] = *(const f32x4*)(gate + col0 + bj * 128 + 4 * n);
#pragma unroll
        for (int ai = 0; ai < 2; ++ai)
#pragma unroll
            for (int m = 0; m < 4; ++m) { const int row = u.pm * 256 + ai * 128 + wr * 64 + m * 16 + fr;
                const float* xin = xrow_ptr(xp, xs, row); float* o = out + (size_t)row * DM;
#pragma unroll
                for (int bj = 0; bj < 2; ++bj)
#pragma unroll
                    for (int n = 0; n < 2; ++n) { const int c = col0 + bj * 128 + 4 * n; const f32x4 xv = *(const f32x4*)(xin + c); *(f32x4*)(o + c) = xv + gv[bj][n] * acc[ai][bj][m][n]; } }
    }
};

__device__ __forceinline__ void qk_norm_rope(float* x1, float* x2, const float* gam, int d1, bool rope, const float* cs, const float* sn, float scale) {
    float ss = 0.f;
#pragma unroll
    for (int i = 0; i < 8; ++i) ss += x1[i] * x1[i] + x2[i] * x2[i];
    ss += shx<1>(ss, 0); ss += shx<2>(ss, 0); ss += shx<4>(ss, 0);
    const float rstd = rsqrtf(ss * (1.f / 128.f) + EPSN);
#pragma unroll
    for (int i = 0; i < 8; ++i) { float a = x1[i] * rstd * gam[d1 + i], b = x2[i] * rstd * gam[d1 + 32 + i];
        if (rope) { const float ra = a * cs[i] - b * sn[i], rb = b * cs[i] + a * sn[i]; a = ra; b = rb; }
        x1[i] = a * scale; x2[i] = b * scale; }
}

__device__ __forceinline__ void attn_item(const Prm& p, int l, bool lat, int b, int kvh, int qb, unsigned char* lds) {
    int tid_ = threadIdx.x; asm volatile("" : "+v"(tid_)); const int tid = tid_, lane = tid & 63, w = tid >> 6, fr = lane & 15, q4 = lane >> 4;
    const int T = lat ? 4096 : 256, rowbase = lat ? NCTX_ROWS + b * 4096 : b * 256, q0 = qb * 64;
    const bf16* P = (const bf16*)(p.ws + WS_P); bf16* MIX = (bf16*)(p.ws + WS_H);
    const bf16* Kc = (const bf16*)(p.ws + WS_KC); const bf16* Vct = (const bf16*)(p.ws + WS_VCT);
    bf16* Qs = (bf16*)(lds + 71680);
    const float* qg = p.qg + l * 128; const float* kg = p.kg + l * 128;
    const int ki8 = tid >> 3, u8 = tid & 7, ax = u8 >> 2, fg = u8 & 3, d1 = ax * 64 + fg * 8;
#define AT_FREQ(i) __builtin_amdgcn_exp2f(-(float)(2 * (fg * 8 + (i))) * (13.287712379549449f / 64.f))
    int i_lo = 0, nloc = 4, ncache = 0;
    if (lat) { i_lo = q0 >= 128 ? 0 : (128 - q0) >> 6; const int i_hi = min(4, (T + 64 - q0) >> 6); nloc = i_hi - i_lo + 1; ncache = 8; }
    const int nb = nloc + ncache;
    const size_t cbase = ((((size_t)b * 2 + l) * 2 + kvh) * 8) * 8192;
    u32x4 rA0, rA1, rA2, rA3;
#define AT_KP0(j) (lat ? q0 - 128 + 64 * (i_lo + (j)) : 64 * (j))
#define AT_LOAD(j, r0, r1, r2, r3) do { if ((j) < nloc) { const int kp0_ = AT_KP0(j); \
            const bf16* ks_ = P + (size_t)(rowbase + kp0_ + ki8) * NP + C_AK + kvh * 128 + d1; r0 = *(const u32x4*)ks_; r1 = *(const u32x4*)(ks_ + 32); \
            const bf16* vs_ = P + (size_t)(rowbase + kp0_ + (tid & 63)) * NP + C_AV + kvh * 128 + (tid >> 6) * 16; r2 = *(const u32x4*)vs_; r3 = *(const u32x4*)(vs_ + 8); } \
        else { const size_t o_ = cbase + (size_t)((j) - nloc) * 8192 + tid * 8; r0 = *(const u32x4*)(Kc + o_); r1 = *(const u32x4*)(Kc + o_ + 4096); r2 = *(const u32x4*)(Vct + o_); r3 = *(const u32x4*)(Vct + o_ + 4096); } } while (0)
#define AT_WRITE(j, Ks, Vt, r0, r1, r2, r3) do { if ((j) < nloc) { const int kp0_ = AT_KP0(j); const int t_ = kp0_ + ki8, pos_ = ax ? (t_ & 63) : (t_ >> 6); \
            float cs_[8], sn_[8], x1_[8], x2_[8]; \
            _Pragma("unroll") for (int i = 0; i < 8; ++i) { const float a_ = (float)pos_ * AT_FREQ(i); cs_[i] = __cosf(a_); sn_[i] = __sinf(a_); } \
            unpack8(r0, x1_); unpack8(r1, x2_); qk_norm_rope(x1_, x2_, kg, d1, lat, cs_, sn_, 1.f); \
            *(u32x4*)((Ks) + ki8 * 136 + d1) = pack8(x1_); *(u32x4*)((Ks) + ki8 * 136 + d1 + 32) = pack8(x2_); \
            if (!lat && (j) == qb) { int tz_ = t_ * 128 + d1; asm volatile("" : "+v"(tz_)); float* ko = p.out + OUT_K + ((((size_t)b * 2 + l) * 2 + kvh) * 256) * 128 + tz_; \
                *(f32x4*)ko = (f32x4){x1_[0], x1_[1], x1_[2], x1_[3]}; *(f32x4*)(ko + 4) = (f32x4){x1_[4], x1_[5], x1_[6], x1_[7]}; \
                *(f32x4*)(ko + 32) = (f32x4){x2_[0], x2_[1], x2_[2], x2_[3]}; *(f32x4*)(ko + 36) = (f32x4){x2_[4], x2_[5], x2_[6], x2_[7]}; } \
            const int kiv_ = tid & 63, dg_ = tid >> 6; float v_[16]; unpack8(r2, v_); unpack8(r3, v_ + 8); \
            const int kpos_ = (kiv_ & 32) + perm32(kiv_ & 31); \
            _Pragma("unroll") for (int i = 0; i < 16; ++i) (Vt)[(dg_ * 16 + i) * 72 + kpos_] = f2bf1(v_[i]); \
            if (!lat && (j) == qb) { int kz_ = (kp0_ + kiv_) * 128 + dg_ * 16; asm volatile("" : "+v"(kz_)); float* vo = p.out + OUT_V + ((((size_t)b * 2 + l) * 2 + kvh) * 256) * 128 + kz_; \
                _Pragma("unroll") for (int i = 0; i < 4; ++i) *(f32x4*)(vo + 4 * i) = (f32x4){v_[4 * i], v_[4 * i + 1], v_[4 * i + 2], v_[4 * i + 3]}; } } \
        else { *(u32x4*)((Ks) + (tid >> 4) * 136 + (tid & 15) * 8) = r0; *(u32x4*)((Ks) + (32 + (tid >> 4)) * 136 + (tid & 15) * 8) = r1; \
            *(u32x4*)((Vt) + (tid >> 3) * 72 + (tid & 7) * 8) = r2; *(u32x4*)((Vt) + (64 + (tid >> 3)) * 72 + (tid & 7) * 8) = r3; } } while (0)
    __syncthreads();
    AT_LOAD(0, rA0, rA1, rA2, rA3);
    {
        const int t = q0 + ki8, pos = ax ? (t & 63) : (t >> 6);
        float cs[8], sn[8];
#pragma unroll
        for (int i = 0; i < 8; ++i) { const float a = (float)pos * AT_FREQ(i); cs[i] = __cosf(a); sn[i] = __sinf(a); }
#pragma unroll
        for (int g = 0; g < 4; ++g) {
            const bf16* src = P + (size_t)(rowbase + t) * NP + C_AQ + (kvh * 4 + g) * 128 + d1;
            float x1[8], x2[8]; unpack8(__builtin_nontemporal_load((const u32x4*)src), x1); unpack8(__builtin_nontemporal_load((const u32x4*)(src + 32)), x2);
            qk_norm_rope(x1, x2, qg, d1, lat, cs, sn, 0.08838834764831845f * LOG2E);
            *(u32x4*)(Qs + (g * 64 + ki8) * 136 + d1) = pack8(x1); *(u32x4*)(Qs + (g * 64 + ki8) * 136 + d1 + 32) = pack8(x2);
        }
    }
    AT_WRITE(0, (bf16*)lds, (bf16*)lds + 8704, rA0, rA1, rA2, rA3);
    if (1 < nb) AT_LOAD(1, rA0, rA1, rA2, rA3);
    __syncthreads();
    const int g = w >> 1, qh = w & 1, head = kvh * 4 + g;
    bf16x8 qfr[2][4];
    {   const bf16* Qw = Qs + (g * 64 + qh * 32 + fr) * 136 + q4 * 8;
#pragma unroll
        for (int ks = 0; ks < 4; ++ks) { qfr[0][ks] = *(const bf16x8*)(Qw + ks * 32); qfr[1][ks] = *(const bf16x8*)(Qw + 16 * 136 + ks * 32); } }
    if (1 < nb) AT_WRITE(1, (bf16*)lds + 17920, (bf16*)lds + 17920 + 8704, rA0, rA1, rA2, rA3);
    __syncthreads();
    f32x4 O[8][2];
#pragma unroll
    for (int dt = 0; dt < 8; ++dt) { O[dt][0] = (f32x4){0.f, 0.f, 0.f, 0.f}; O[dt][1] = (f32x4){0.f, 0.f, 0.f, 0.f}; }
    const float sk = p.sink[l * 8 + head] * LOG2E;
    const float nsk = -sk; float lsum[2] = {q4 == 0 ? 1.f : 0.f, q4 == 0 ? 1.f : 0.f};
#define AT_COMPUTE(j, KsP, VtP) do { const bf16* Ks = (KsP); const bf16* Vt = (VtP); \
        __builtin_amdgcn_s_setprio(1); \
        f32x4 sT[4][2]; \
_Pragma("unroll") \
        for (int mt = 0; mt < 4; ++mt) { sT[mt][0] = (f32x4){nsk, nsk, nsk, nsk}; sT[mt][1] = (f32x4){nsk, nsk, nsk, nsk}; } \
_Pragma("unroll") \
        for (int ks = 0; ks < 4; ++ks) { const bf16x8 q0f = qfr[0][ks], q1f = qfr[1][ks]; \
_Pragma("unroll") \
            for (int mt = 0; mt < 4; ++mt) { const bf16x8 kf = *(const bf16x8*)(Ks + (mt * 16 + fr) * 136 + ks * 32 + q4 * 8); \
                sT[mt][0] = mfma16(kf, q0f, sT[mt][0]); sT[mt][1] = mfma16(kf, q1f, sT[mt][1]); } } \
        if (lat && j < nloc && (i_lo + j == 0 || i_lo + j == 4)) { const int kp0 = AT_KP0(j); \
_Pragma("unroll") \
            for (int mt = 0; mt < 4; ++mt) \
_Pragma("unroll") \
                for (int nt = 0; nt < 2; ++nt) \
_Pragma("unroll") \
                    for (int i = 0; i < 4; ++i) { const int kpos = kp0 + mt * 16 + q4 * 4 + i, qpos = q0 + qh * 32 + nt * 16 + fr; const int dd = kpos - qpos; \
                        if (dd > 128 || dd < -128) sT[mt][nt][i] = -1e30f; } \
        } \
        bf16x8 pf[2][2]; \
_Pragma("unroll") \
        for (int nt = 0; nt < 2; ++nt) { \
            float ps = 0.f; \
_Pragma("unroll") \
            for (int mt = 0; mt < 4; ++mt) \
_Pragma("unroll") \
                for (int i = 0; i < 4; ++i) { const float pv = __builtin_amdgcn_exp2f(sT[mt][nt][i]); sT[mt][nt][i] = pv; ps += pv; } \
            lsum[nt] += ps; \
            pf[nt][0] = pack8f(sT[0][nt], sT[1][nt]); pf[nt][1] = pack8f(sT[2][nt], sT[3][nt]); \
        } \
_Pragma("unroll") \
        for (int kk = 0; kk < 2; ++kk) \
_Pragma("unroll") \
            for (int dt = 0; dt < 8; ++dt) { const bf16x8 vf = *(const bf16x8*)(Vt + (dt * 16 + fr) * 72 + 32 * kk + q4 * 8); \
                O[dt][0] = mfma16(vf, pf[0][kk], O[dt][0]); O[dt][1] = mfma16(vf, pf[1][kk], O[dt][1]); } \
        __builtin_amdgcn_s_setprio(0); \
    } while (0)
    for (int jj = 0; jj < nb; jj += 2) {
        const int pp = (jj >> 1) & 1;
        bf16* c0 = (bf16*)(lds + (2 * pp) * 35840); bf16* c1 = c0 + 17920; bf16* n0 = (bf16*)(lds + (2 - 2 * pp) * 35840); bf16* n1 = n0 + 17920;
        if (jj + 2 < nb) AT_LOAD(jj + 2, rA0, rA1, rA2, rA3);
        AT_COMPUTE(jj, c0, c0 + 8704);
        if (jj + 2 < nb) AT_WRITE(jj + 2, n0, n0 + 8704, rA0, rA1, rA2, rA3);
        if (jj + 1 < nb) {
            if (jj + 3 < nb) AT_LOAD(jj + 3, rA0, rA1, rA2, rA3);
            AT_COMPUTE((jj + 1), c1, c1 + 8704);
            if (jj + 3 < nb) AT_WRITE(jj + 3, n1, n1 + 8704, rA0, rA1, rA2, rA3);
        }
        __syncthreads();
    }
#undef AT_COMPUTE
#undef AT_KP0
#undef AT_FREQ
#undef AT_LOAD
#undef AT_WRITE
#pragma unroll
    for (int nt = 0; nt < 2; ++nt) {
        float lt = lsum[nt]; lt += shx<16>(lt, 0); lt += shx<32>(lt, lane);
        const float inv = __builtin_amdgcn_rcpf(lt);
        const int row = rowbase + q0 + qh * 32 + nt * 16 + fr;
#pragma unroll
        for (int dt = 0; dt < 8; ++dt) { const int d = dt * 16 + q4 * 4;
            const u32x2 gv = __builtin_nontemporal_load((const u32x2*)(P + (size_t)row * NP + C_AG + head * 128 + d));
            const float g0 = bf2f(gv.x & 0xffffu), g1 = __builtin_bit_cast(float, gv.x & 0xffff0000u), g2 = bf2f(gv.y & 0xffffu), g3 = __builtin_bit_cast(float, gv.y & 0xffff0000u);
            u32x2 o; o.x = cvtpk(O[dt][nt][0] * inv * silu_f(g0), O[dt][nt][1] * inv * silu_f(g1)); o.y = cvtpk(O[dt][nt][2] * inv * silu_f(g2), O[dt][nt][3] * inv * silu_f(g3));
            *(u32x2*)(MIX + (size_t)row * DM + head * 128 + d) = o; }
    }
}

__device__ __forceinline__ float rcp_f(float x) { return __builtin_amdgcn_rcpf(x); }
__device__ __forceinline__ void hgrn_item(const Prm& p, int l, int s, int h, int seg, int mode, unsigned char* lds) {
    int tid_ = threadIdx.x; asm volatile("" : "+v"(tid_)); const int tid = tid_, lane = tid & 63, w = tid >> 6, fr = lane & 15, q4 = lane >> 4;
    const bool lat = mode != 0, do_out = mode != 1; const int b = lat ? s - 16 : s, T = lat ? 4096 : 256, rowbase = lat ? NCTX_ROWS + b * 4096 : b * 256, nCh = lat ? 16 : 8;
    const bf16* P = (const bf16*)(p.ws + WS_P); bf16* MIX = (bf16*)(p.ws + WS_H); bf16* Ob = (bf16*)(p.ws + WS_O);
    const int dir = w >> 2, sl = w & 3, dtid = tid & 255, d = dtid & 127, th = dtid >> 7;
    const int sseg = lat ? ((dir && mode == 2) ? 7 - seg : seg) : 0, c0 = sseg * 16;
    unsigned char* L = lds + dir * 65536;
    const bf16* rawZ = (const bf16*)L; const bf16* rawQ = (const bf16*)(L + 8192); const bf16* rawV = (const bf16*)(L + 16384);
    bf16* qe = (bf16*)(L + 24576); bf16* ke = (bf16*)(L + 33280); bf16* kdT = (bf16*)(L + 41984); bf16* vT = (bf16*)(L + 52224); float* eb = (float*)(L + 62464); float* tot = (float*)(L + 62976);
    float lb = 0.f;
    if (l == 1) { const float x0 = p.hlb[(0 * 2 + dir) * 512 + h * 128 + d], x1 = p.hlb[(1 * 2 + dir) * 512 + h * 128 + d]; lb = rcp_f(1.f + __expf(x0 - x1)); }
    const float omlb = 1.f - lb;
    unsigned* dep = (unsigned*)(p.ws + WS_CTL) + 256 + (l * 32 + b * 4 + h);
    if (mode == 2) {
        if (w == 0) { if (lane == 0) { while (__hip_atomic_load(dep, __ATOMIC_RELAXED, __HIP_MEMORY_SCOPE_AGENT) < 7u) __builtin_amdgcn_s_sleep(8); }
            __builtin_amdgcn_fence(__ATOMIC_ACQUIRE, "agent"); }
        __syncthreads();
    }
    f32x4 S[8][2];
    const size_t sbase = ((((size_t)b * 2 + l) * 2 + dir) * 4 + h) * 16384;
    float* sloc = (float*)(p.ws + WS_SLOC) + ((((size_t)b * 4 + h) * 2 + dir) * 8) * 16384;
    float* dlg = (float*)(p.ws + WS_DLOG) + ((((size_t)b * 4 + h) * 2 + dir) * 8) * 128;
    const int soff = sl * 32 + fr;
#pragma unroll
    for (int dm = 0; dm < 8; ++dm) { S[dm][0] = (f32x4){0.f, 0.f, 0.f, 0.f}; S[dm][1] = (f32x4){0.f, 0.f, 0.f, 0.f}; }
    if (mode == 2) {
        const float* stp = p.state + sbase + q4 * 512 + soff; asm volatile("" : "+v"(stp));
#pragma unroll
        for (int dm = 0; dm < 8; ++dm)
#pragma unroll
            for (int nn = 0; nn < 2; ++nn)
#pragma unroll
                for (int i = 0; i < 4; ++i) S[dm][nn][i] = stp[(dm * 16 + i) * 128 + nn * 16];
        for (int j = 0; j < sseg; ++j) {
            const float* sp = sloc + (size_t)j * 16384 + q4 * 512 + soff; asm volatile("" : "+v"(sp));
            const float* dp = dlg + j * 128 + q4 * 4; asm volatile("" : "+v"(dp));
#pragma unroll
            for (int dm = 0; dm < 8; ++dm) { const f32x4 dl = *(const f32x4*)(dp + dm * 16);
#pragma unroll
                for (int nn = 0; nn < 2; ++nn)
#pragma unroll
                    for (int i = 0; i < 4; ++i) S[dm][nn][i] = S[dm][nn][i] * __builtin_amdgcn_exp2f(dl[i]) + sp[(dm * 16 + i) * 128 + nn * 16]; }
        }
    }
    bf16* Od = Ob + (size_t)dir * M_ROWS * 512;
    float dacc = 0.f;
    const int zc0 = (dir ? C_BFB : C_BFF) + h * 128, qc0 = C_BQ + h * 128, vc0 = C_BI + h * 128;
    const int ur = dtid >> 4, uc = (dtid & 15) * 8;
    u32x4 pre[6];
#define HG_LOAD(cidx) do { const int cr_ = rowbase + (dir ? T - 32 * ((cidx) + 1) : 32 * (cidx)); \
        _Pragma("unroll") for (int k = 0; k < 2; ++k) { const bf16* pr_ = P + (size_t)(cr_ + ur + 16 * k) * NP + uc; \
            pre[k] = *(const u32x4*)(pr_ + zc0); pre[2 + k] = *(const u32x4*)(pr_ + vc0); if (do_out) pre[4 + k] = *(const u32x4*)(pr_ + qc0); } } while (0)
#define HG_STORE() do { _Pragma("unroll") for (int k = 0; k < 2; ++k) { const int o_ = (ur + 16 * k) * 128 + uc; \
            *(u32x4*)(L + 2 * o_) = pre[k]; *(u32x4*)(L + 16384 + 2 * o_) = pre[2 + k]; if (do_out) *(u32x4*)(L + 8192 + 2 * o_) = pre[4 + k]; } } while (0)
    __syncthreads();
    HG_LOAD(c0); HG_STORE();
    if (nCh > 1) HG_LOAD(c0 + 1);
    __syncthreads();
    for (int cc = 0; cc < nCh; ++cc) {
        const int c = c0 + cc;
        const int crow0 = rowbase + (dir ? T - 32 * (c + 1) : 32 * c);
        float Fp[16], kk[16]; unsigned qpk[8], vpk[8]; float runa = 1.f, runb = 1.f;
#pragma unroll
        for (int ii = 0; ii < 16; ++ii) { const int i = (ii < 8 ? th * 8 + ii : 8 + th * 8 + ii), ro = (dir ? 31 - i : i) * 128 + d;
            const unsigned vz = rawV[ro], qz = rawQ[ro];
            if (ii & 1) { vpk[ii >> 1] |= vz << 16; qpk[ii >> 1] |= qz << 16; } else { vpk[ii >> 1] = vz; qpk[ii >> 1] = qz; }
            float z = bf2f(rawZ[ro]);
            z = fminf(fmaxf(z, -60.f), 60.f);
            const float e = __expf(-z), sg = rcp_f(1.f + e), f = lb + omlb * sg;
            if (ii < 8) { runa *= f; Fp[ii] = runa; } else { runb *= f; Fp[ii] = runb; }
            kk[ii] = omlb * (e * sg); }
        tot[th * 128 + d] = runa; tot[(2 + th) * 128 + d] = runb;
        __syncthreads();
        {   const float oa = tot[(1 - th) * 128 + d], ob = tot[(3 - th) * 128 + d];
            const float offa = th ? oa : 1.f;
            const float offb = th ? oa * runa * ob : runa * oa;
            const float Flast = runa * runb * oa * ob;
            const int pd = (d & ~31) + perm32(d & 31);
#pragma unroll
            for (int hh = 0; hh < 2; ++hh) {
                float kd[8];
#pragma unroll
                for (int x = 0; x < 8; ++x) { const int ii = (x < 4 ? 4 * hh + x : 8 + 4 * hh + (x - 4));
                    const float Fx = Fp[ii] * (ii < 8 ? offa : offb), rx = rcp_f(Fx); kd[x] = kk[ii] * (Flast * rx); kk[ii] *= rx; Fp[ii] = Fx; }
                u32x4 w0; w0.x = cvtpk(kd[0], kd[1]); w0.y = cvtpk(kd[2], kd[3]); w0.z = cvtpk(kd[4], kd[5]); w0.w = cvtpk(kd[6], kd[7]);
                *(u32x4*)(kdT + d * 40 + th * 16 + 8 * hh) = w0;
                u32x4 v0; v0.x = vpk[2 * hh]; v0.y = vpk[2 * hh + 1]; v0.z = vpk[4 + 2 * hh]; v0.w = vpk[4 + 2 * hh + 1];
                *(u32x4*)(vT + d * 40 + th * 16 + 8 * hh) = v0; }
            if (do_out) {
#pragma unroll
                for (int ii = 0; ii < 16; ii += 2) { const int i = (ii < 8 ? th * 8 + ii : 8 + th * 8 + ii);
                    const float q0 = bf2f(qpk[ii >> 1] & 0xffffu), q1 = __builtin_bit_cast(float, qpk[ii >> 1] & 0xffff0000u);
                    qe[i * 136 + pd] = f2bf1(silu_f(q0) * Fp[ii]); qe[(i + 1) * 136 + pd] = f2bf1(silu_f(q1) * Fp[ii + 1]);
                    ke[i * 136 + pd] = f2bf1(kk[ii]); ke[(i + 1) * 136 + pd] = f2bf1(kk[ii + 1]); } }
            if (th == 0) { eb[d] = Flast; dacc += __log2f(Flast); } }
        if (cc + 1 < nCh) HG_STORE();
        __syncthreads();
        bf16x8 vf[2];
#pragma unroll
        for (int nn = 0; nn < 2; ++nn) vf[nn] = *(const bf16x8*)(vT + (sl * 32 + nn * 16 + fr) * 40 + q4 * 8);
        if (do_out) {
            f32x4 aT[2][2], o[2][2];
#pragma unroll
            for (int x = 0; x < 2; ++x) { aT[x][0] = (f32x4){0.f, 0.f, 0.f, 0.f}; aT[x][1] = (f32x4){0.f, 0.f, 0.f, 0.f}; o[x][0] = (f32x4){0.f, 0.f, 0.f, 0.f}; o[x][1] = (f32x4){0.f, 0.f, 0.f, 0.f}; }
#pragma unroll
            for (int ks = 0; ks < 4; ++ks) {
                const bf16x8 q0f = *(const bf16x8*)(qe + fr * 136 + ks * 32 + q4 * 8), q1f = *(const bf16x8*)(qe + (16 + fr) * 136 + ks * 32 + q4 * 8);
                const bf16x8 k0f = *(const bf16x8*)(ke + fr * 136 + ks * 32 + q4 * 8), k1f = *(const bf16x8*)(ke + (16 + fr) * 136 + ks * 32 + q4 * 8);
                aT[0][0] = mfma16(k0f, q0f, aT[0][0]); aT[0][1] = mfma16(k0f, q1f, aT[0][1]); aT[1][0] = mfma16(k1f, q0f, aT[1][0]); aT[1][1] = mfma16(k1f, q1f, aT[1][1]);
#pragma unroll
                for (int nn = 0; nn < 2; ++nn) { const bf16x8 sf = pack8f(S[2 * ks][nn], S[2 * ks + 1][nn]);
                    o[0][nn] = mfma16(sf, q0f, o[0][nn]); o[1][nn] = mfma16(sf, q1f, o[1][nn]); }
            }
#pragma unroll
            for (int mt = 0; mt < 2; ++mt)
#pragma unroll
                for (int nt = 0; nt < 2; ++nt)
#pragma unroll
                    for (int i = 0; i < 4; ++i) if (mt * 16 + q4 * 4 + i > nt * 16 + fr) aT[mt][nt][i] = 0.f;
#pragma unroll
            for (int tt = 0; tt < 2; ++tt) { const bf16x8 af = pack8f(aT[0][tt], aT[1][tt]);
                o[tt][0] = mfma16(vf[0], af, o[tt][0]); o[tt][1] = mfma16(vf[1], af, o[tt][1]); }
#pragma unroll
            for (int tt = 0; tt < 2; ++tt) { const int t = tt * 16 + fr, r = dir ? 31 - t : t; bf16* ob_ = Od + (size_t)(crow0 + r) * 512 + h * 128 + sl * 32 + q4 * 4;
#pragma unroll
                for (int nn = 0; nn < 2; ++nn) { u32x2 ov; ov.x = cvtpk(o[tt][nn][0], o[tt][nn][1]); ov.y = cvtpk(o[tt][nn][2], o[tt][nn][3]); *(u32x2*)(ob_ + nn * 16) = ov; } }
        }
        if (cc + 2 < nCh) HG_LOAD(c + 2);
#pragma unroll
        for (int dm = 0; dm < 8; ++dm) { const bf16x8 kdf = *(const bf16x8*)(kdT + (dm * 16 + fr) * 40 + q4 * 8); const f32x4 e4 = *(const f32x4*)(eb + dm * 16 + q4 * 4);
            S[dm][0] = mfma16(kdf, vf[0], S[dm][0] * e4); S[dm][1] = mfma16(kdf, vf[1], S[dm][1] * e4); }
    }
#undef HG_LOAD
#undef HG_STORE
    if (mode != 2) {
        float* so = (mode == 0 ? p.out + OUT_S + sbase : sloc + (size_t)sseg * 16384) + q4 * 512 + soff; asm volatile("" : "+v"(so));
#pragma unroll
        for (int dm = 0; dm < 8; ++dm)
#pragma unroll
            for (int nn = 0; nn < 2; ++nn)
#pragma unroll
                for (int i = 0; i < 4; ++i) __hip_atomic_store(so + (dm * 16 + i) * 128 + nn * 16, S[dm][nn][i], __ATOMIC_RELAXED, __HIP_MEMORY_SCOPE_AGENT);
        if (mode == 1 && th == 0) __hip_atomic_store(dlg + sseg * 128 + d, dacc, __ATOMIC_RELAXED, __HIP_MEMORY_SCOPE_AGENT);
        if (mode == 1) { asm volatile("s_waitcnt vmcnt(0)" ::: "memory"); __syncthreads(); if (tid == 0) __hip_atomic_fetch_add(dep, 1u, __ATOMIC_RELAXED, __HIP_MEMORY_SCOPE_AGENT); }
    }
    if (do_out) {
        asm volatile("s_waitcnt vmcnt(0)" ::: "memory");
        __syncthreads();
        const int rr = tid >> 4, part = tid & 15; const float* hg = p.hg + l * 128 + part * 8;
        float hgv[8];
#pragma unroll
        for (int i = 0; i < 8; ++i) hgv[i] = hg[i];
        const int r0 = rowbase + (lat ? seg * 512 : 0), nIt = lat ? 4 : 2;
        for (int it = 0; it < nIt; ++it) {
            u32x4 af4[4], bf4[4], gt4[4];
#pragma unroll
            for (int k = 0; k < 4; ++k) { const int row = r0 + it * 128 + k * 32 + rr; const bf16* a = Ob + (size_t)row * 512 + h * 128 + part * 8;
                af4[k] = __builtin_nontemporal_load((const u32x4*)a); bf4[k] = __builtin_nontemporal_load((const u32x4*)(a + (size_t)M_ROWS * 512));
                gt4[k] = __builtin_nontemporal_load((const u32x4*)(P + (size_t)row * NP + C_BG + h * 128 + part * 8)); }
#pragma unroll
            for (int k = 0; k < 4; ++k) { const int row = r0 + it * 128 + k * 32 + rr;
                float ov[8], ob8[8]; unpack8(af4[k], ov); unpack8(bf4[k], ob8);
#pragma unroll
                for (int i = 0; i < 8; ++i) ov[i] += ob8[i];
                float ss = 0.f;
#pragma unroll
                for (int i = 0; i < 8; ++i) ss += ov[i] * ov[i];
                ss += shx<1>(ss, 0); ss += shx<2>(ss, 0); ss += shx<4>(ss, 0); ss += shx<8>(ss, 0);
                const float rstd = rsqrtf(ss * (1.f / 128.f) + EPSN);
                float gt[8]; unpack8(gt4[k], gt);
#pragma unroll
                for (int i = 0; i < 8; ++i) ov[i] = ov[i] * rstd * hgv[i] * (gt[i] * rcp_f(1.f + __expf(-gt[i])));
                *(u32x4*)(MIX + (size_t)row * DM + 1024 + h * 128 + part * 8) = pack8(ov); }
        }
    }
}

__device__ __forceinline__ void sgu_item(const Prm& p, int l, int n, unsigned char* lds) {
    int tid_ = threadIdx.x; asm volatile("" : "+v"(tid_)); const int tid = tid_, lane = tid & 63, w = tid >> 6, fr = lane & 15, q4 = lane >> 4;
    const bf16* P = (const bf16*)(p.ws + WS_P); bf16* MIX = (bf16*)(p.ws + WS_H);
    const int row0 = n * 128;
    float* stats = (float*)lds; bf16* vnT = (bf16*)(lds + 1024);
    __syncthreads();
    {   const int q = tid >> 2, part = tid & 3; const bf16* src = P + (size_t)(row0 + q) * NP + C_CV + part * 128;
        float s = 0.f, ss = 0.f;
#pragma unroll
        for (int i = 0; i < 16; ++i) { float v[8]; unpack8(*(const u32x4*)(src + 8 * i), v);
#pragma unroll
            for (int k = 0; k < 8; ++k) { s += v[k]; ss += v[k] * v[k]; } }
        s += shx<1>(s, 0); s += shx<2>(s, 0); ss += shx<1>(ss, 0); ss += shx<2>(ss, 0);
        const float mean = s * (1.f / 512.f), var = fmaxf(ss * (1.f / 512.f) - mean * mean, 0.f);
        if (part == 0) { stats[2 * q] = mean; stats[2 * q + 1] = rsqrtf(var + EPSN); } }
    __syncthreads();
    const int qp = tid >> 3, cp = tid & 7;
    const float m0 = stats[4 * qp], r0s = stats[4 * qp + 1], m1 = stats[4 * qp + 2], r1s = stats[4 * qp + 3];
    const int prow = row0 + w * 16 + fr;
    for (int g = 0; g < 4; ++g) {
        {   const bf16* s0 = P + (size_t)(row0 + 2 * qp) * NP + C_CV + g * 128 + cp * 16;
            float a[16], bq[16]; unpack8(*(const u32x4*)s0, a); unpack8(*(const u32x4*)(s0 + 8), a + 8); unpack8(*(const u32x4*)(s0 + NP), bq); unpack8(*(const u32x4*)(s0 + NP + 8), bq + 8);
            const float* gp = p.lng + l * 512 + g * 128 + cp * 16; const float* bp = p.lnb + l * 512 + g * 128 + cp * 16;
#pragma unroll
            for (int k = 0; k < 4; ++k) { const f32x4 gv = *(const f32x4*)(gp + 4 * k), bv = *(const f32x4*)(bp + 4 * k);
#pragma unroll
                for (int i = 0; i < 4; ++i) { const int c = 4 * k + i;
                    *(unsigned*)(vnT + (cp * 16 + c) * 136 + 2 * qp) = cvtpk((a[c] - m0) * r0s * gv[i] + bv[i], (bq[c] - m1) * r1s * gv[i] + bv[i]); } } }
        __syncthreads();
        bf16x8 wf[4];
        {   const float* wsrc = p.sgw + (((size_t)l * 4 + g) * 128 + w * 16 + fr) * 128 + q4 * 8;
#pragma unroll
            for (int ks = 0; ks < 4; ++ks) { const f32x4 a = *(const f32x4*)(wsrc + ks * 32), bq = *(const f32x4*)(wsrc + ks * 32 + 4); wf[ks] = pack8f(a, bq); } }
        const float bsv = p.sgb[((size_t)l * 4 + g) * 128 + w * 16 + fr];
        const bf16* pr = P + (size_t)prow * NP + g * 128 + q4 * 4;
        u32x2 uu[8], gg[8];
#pragma unroll
        for (int nt = 0; nt < 8; ++nt) { uu[nt] = *(const u32x2*)(pr + C_CU + nt * 16); gg[nt] = *(const u32x2*)(pr + C_CG + nt * 16); }
#pragma unroll
        for (int nt = 0; nt < 8; ++nt) { f32x4 acc = (f32x4){0.f, 0.f, 0.f, 0.f};
#pragma unroll
            for (int ks = 0; ks < 4; ++ks) acc = mfma16(*(const bf16x8*)(vnT + (nt * 16 + fr) * 136 + ks * 32 + q4 * 8), wf[ks], acc);
            const float u0 = bf2f(uu[nt].x & 0xffffu), u1 = __builtin_bit_cast(float, uu[nt].x & 0xffff0000u), u2 = bf2f(uu[nt].y & 0xffffu), u3 = __builtin_bit_cast(float, uu[nt].y & 0xffff0000u);
            const float g0 = bf2f(gg[nt].x & 0xffffu), g1 = __builtin_bit_cast(float, gg[nt].x & 0xffff0000u), g2 = bf2f(gg[nt].y & 0xffffu), g3 = __builtin_bit_cast(float, gg[nt].y & 0xffff0000u);
            u32x2 o; o.x = cvtpk(u0 * (acc[0] + bsv) * silu_f(g0), u1 * (acc[1] + bsv) * silu_f(g1)); o.y = cvtpk(u2 * (acc[2] + bsv) * silu_f(g2), u3 * (acc[3] + bsv) * silu_f(g3));
            *(u32x2*)(MIX + (size_t)prow * DM + 1536 + g * 128 + nt * 16 + q4 * 4) = o; }
        __syncthreads();
    }
}

#define LAS __attribute__((address_space(3)))
#define XB_TMO      128
#define XB_XCNT(j)  (256  + 64 * (j))
#define XB_XSUB(j)  (1280 + 64 * (j))
#define XB_XGEN(j)  (2304 + 64 * (j))
#define XB_TOP      3328
#define XB_TOPGEN   3392
#define XCD_BAR_WORDS 3456
#define XB_SPIN_CAP (1u << 18)

__device__ __forceinline__ unsigned xb_ld(unsigned* p)              { return __hip_atomic_load(p, __ATOMIC_RELAXED, __HIP_MEMORY_SCOPE_AGENT); }
__device__ __forceinline__ unsigned xb_add(unsigned* p, unsigned v) { return __hip_atomic_fetch_add(p, v, __ATOMIC_RELAXED, __HIP_MEMORY_SCOPE_AGENT); }
__device__ __forceinline__ unsigned xb_xcc_id() { return (unsigned)__builtin_amdgcn_s_getreg((3 << 11) | 20) & 0xFu; }
#define XB_SPIN(cond, bar) do { unsigned _sp = 0; while (cond) { __builtin_amdgcn_s_sleep(1); \
    if ((++_sp & 255u) == 0u) { if (xb_ld(&(bar)[XB_TMO])) break; if (_sp > XB_SPIN_CAP) { atomicAdd(&(bar)[XB_TMO], 1u); break; } } } } while (0)

struct XcdBarrier {
    unsigned* bar; unsigned x;
    volatile LAS unsigned* st;
};

__device__ __forceinline__ XcdBarrier xcd_barrier_post(unsigned* bar, volatile LAS unsigned* st) {
    XcdBarrier b; b.bar = bar; b.x = xb_xcc_id(); b.st = st;
    if (threadIdx.x == 0) (void)xb_add(&bar[XB_XCNT(b.x)], 1u);
    return b;
}
__device__ __forceinline__ void xcd_barrier_complete(unsigned* bar, unsigned x, unsigned& nloc, unsigned& nx) {
    const unsigned G = gridDim.x * gridDim.y * gridDim.z;
    unsigned sum, cnt, mine, sp = 0u;
    for (;;) {
        sum = 0u; cnt = 0u; mine = 0u;
#pragma unroll
        for (unsigned j = 0; j < 16; ++j) { const unsigned c = xb_ld(&bar[XB_XCNT(j)]); sum += c; cnt += (c > 0u) ? 1u : 0u; mine = (j == x) ? c : mine; }
        if (sum == G) break;
        __builtin_amdgcn_s_sleep(1);
        if ((++sp & 255u) == 0u) { if (xb_ld(&bar[XB_TMO])) break; if (sp > XB_SPIN_CAP) { atomicAdd(&bar[XB_TMO], 1u); break; } }
    }
    nloc = mine > 0u ? mine : 1u; nx = cnt > 0u ? cnt : 1u;
}

__device__ __forceinline__ void xcd_barrier(const XcdBarrier& b) {
    asm volatile("s_waitcnt vmcnt(0)" ::: "memory");
    __syncthreads();
    if (threadIdx.x == 0) {
        unsigned* bar = b.bar;
        __builtin_amdgcn_s_waitcnt(0);
        unsigned nloc = b.st[0], nx = b.st[1];
        if (nloc == 0u) { xcd_barrier_complete(bar, b.x, nloc, nx); b.st[0] = nloc; b.st[1] = nx; }
        const unsigned old = xb_add(&bar[XB_XSUB(b.x)], 1u);
        const unsigned gen = old / nloc;
        if (old + 1u == (gen + 1u) * nloc) {
            __builtin_amdgcn_fence(__ATOMIC_RELEASE, "agent");
            asm volatile("s_waitcnt vmcnt(0)" ::: "memory");
            const unsigned og = xb_add(&bar[XB_TOP], 1u);
            const unsigned tg = og / nx;
            if (og + 1u == (tg + 1u) * nx) xb_add(&bar[XB_TOPGEN], 1u);
            else XB_SPIN(xb_ld(&bar[XB_TOPGEN]) == tg, bar);
            __builtin_amdgcn_fence(__ATOMIC_ACQUIRE, "agent");
            xb_add(&bar[XB_XGEN(b.x)], 1u);
            asm volatile("s_waitcnt vmcnt(0)" ::: "memory");
        } else {
            XB_SPIN(xb_ld(&bar[XB_XGEN(b.x)]) == gen, bar);
            __builtin_amdgcn_fence(__ATOMIC_ACQUIRE, "agent");
            asm volatile("s_waitcnt vmcnt(0)" ::: "memory");
        }
    }
    __syncthreads();
}

__device__ __forceinline__ unsigned char* g_lds_base() { extern __shared__ __attribute__((aligned(16))) unsigned char lds_[]; return lds_; }
__device__ __forceinline__ void phase_mix(const Prm& p, int l, unsigned char* lds) {
    volatile int* bw = (volatile int*)(lds + LDS_BCAST);
    constexpr int E0 = 28, E1 = E0 + 8, E2 = E1 + 128, E3 = E2 + 32, E4 = E3 + 16, E5 = E4 + 36;
    const int x0 = (int)(xb_xcc_id() & 7u);
    for (int kq = 0; kq < 8; ++kq) {
        const int x = (x0 + kq) & 7;
        unsigned* ctr = (unsigned*)(p.ws + WS_CTL) + 1024 + 64 * (l * 8 + x);
        for (;;) {
            __syncthreads();
            if (threadIdx.x == 0) *bw = (int)atomicAdd(ctr, 1u);
            __syncthreads();
            int it = __builtin_amdgcn_readfirstlane(*bw);
            if (it >= E5) break;
            int type, a0, a1 = 0, a2 = 0, a3 = 0;
            if (it < E0) { type = 0; a0 = 16 + x; a1 = it / 7; a2 = it - a1 * 7; a3 = 1; }
            else if (it < E1) { it -= E0; type = 0; a0 = 2 * x + (it >> 2); a1 = it & 3; a3 = 0; }
            else if (it < E2) { it -= E1; type = 1; a0 = x; a1 = it >> 6; a2 = it & 63; }
            else if (it < E3) { it -= E2; type = 0; a0 = 16 + x; a1 = it >> 3; a2 = it & 7; a3 = 2; }
            else if (it < E4) { it -= E3; type = 2; a0 = 2 * x + (it >> 3); a1 = (it >> 2) & 1; a2 = it & 3; }
            else { type = 3; a0 = x * 36 + (it - E4); }
            if (type == 0) hgrn_item(p, l, a0, a1, a2, a3, lds);
            else if (type == 3) sgu_item(p, l, a0, lds);
            else attn_item(p, l, type == 1, a0, a1, a2, lds);
        }
    }
}

__global__ void __launch_bounds__(512) fwd_mega(Prm p) {
    extern __shared__ __attribute__((aligned(16))) unsigned char lds[];
    cg::grid_group grid = cg::this_grid();
    volatile LAS unsigned* xst = (volatile LAS unsigned*)((LAS unsigned char*)lds + LDS_BCAST + 16);
    if (threadIdx.x < 2) xst[threadIdx.x] = 0u;
    __syncthreads();
    (void)xcd_barrier_post((unsigned*)(p.ws + WS_CTL) + 2048, xst);
#define GRID_BAR() do { XcdBarrier b_; b_.bar = (unsigned*)(p.ws + WS_CTL) + 2048; b_.x = xb_xcc_id(); b_.st = (volatile LAS unsigned*)((LAS unsigned char*)g_lds_base() + LDS_BCAST + 16); xcd_barrier(b_); } while (0)
    phase0(p, lds);
    grid.sync();
#pragma unroll 1
    for (int l_ = 0; l_ < 2; ++l_) {
        int l = l_; asm volatile("" : "+s"(l));
        const float* xp = l == 0 ? p.x_prompt : p.out; const float* xs = l == 0 ? p.x_sample : p.out + (size_t)NCTX_ROWS * DM;
        phase_norm(p, l, xp, xs);
        GRID_BAR();
        {   pg8::Gemm g{(const pg8::bf16_t*)(p.ws + WS_H), (const pg8::bf16_t*)(p.ws + WS_WIN) + (size_t)l * NP * 2048, M_ROWS, NP, 2048};
            pg8::StaticOrder S; S.init(M_ROWS, NP, (int)gridDim.x, (int)blockIdx.x);
            pg8::EpiBf16<0> E{(pg8::bf16_t*)(p.ws + WS_P), NP, nullptr, 0, 0, 1.f};
            pg8::gemm_phase<pg8::EpiBf16<0>, pg8::StaticOrder, true, true>((PG8_LAS unsigned char*)lds, g, S, E); }
        GRID_BAR();
        phase_mix(p, l, lds);
        GRID_BAR();
        {   pg8::Gemm g{(const pg8::bf16_t*)(p.ws + WS_H), (const pg8::bf16_t*)(p.ws + WS_WOUT) + (size_t)l * 2048 * 2048, M_ROWS, 2048, 2048};
            pg8::StaticOrder S; S.init(M_ROWS, 2048, (int)gridDim.x, (int)blockIdx.x);
            EpiResid E{xp, xs, p.out, (const float*)(p.ws + WS_MOD) + (size_t)l * 9 * NMOD};
            pg8::gemm_phase<EpiResid, pg8::StaticOrder, true, true>((PG8_LAS unsigned char*)lds, g, S, E); }
        if (l == 0) GRID_BAR();
    }
}

extern "C" void kernel_launch(void* const* d_in, const int* in_sizes, int n_in, void* d_out, int out_size, void* d_ws, size_t ws_size, hipStream_t stream) {
    static int grid = 0;
    if (grid == 0) {
        if (n_in != 21 || ws_size < WS_END) { fprintf(stderr, "kernel_launch: unexpected n_in %d / ws_size %zu\n", n_in, ws_size); grid = -1; return; }
        int dev = 0, cus = 0, per_cu = 0;
        hipGetDevice(&dev); hipDeviceGetAttribute(&cus, hipDeviceAttributeMultiprocessorCount, dev);
        if (hipFuncSetAttribute((const void*)fwd_mega, hipFuncAttributeMaxDynamicSharedMemorySize, LDS_BYTES) != hipSuccess) { fprintf(stderr, "kernel_launch: hipFuncSetAttribute failed\n"); grid = -1; return; }
        if (hipOccupancyMaxActiveBlocksPerMultiprocessor(&per_cu, (const void*)fwd_mega, 512, LDS_BYTES) != hipSuccess || per_cu < 1) { fprintf(stderr, "kernel_launch: occupancy query %d\n", per_cu); per_cu = 1; }
        (void)hipGetLastError();
        grid = cus * 1;
    }
    if (grid < 0) return;
    hipMemsetAsync((char*)d_ws + WS_CTL, 0, 32768, stream);
    Prm p{};
    const float** pp = (const float**)&p;
    for (int i = 0; i < 21; ++i) pp[i] = (const float*)d_in[i];
    p.out = (float*)d_out; p.ws = (unsigned char*)d_ws;
    void* args[] = {&p};
    hipError_t e = hipLaunchCooperativeKernel((const void*)fwd_mega, dim3(grid), dim3(512), args, LDS_BYTES, stream);
    if (e != hipSuccess) fprintf(stderr, "cooperative launch failed: %s (grid %d)\n", hipGetErrorString(e), grid);
}
```

```cpp
#include <hip/hip_runtime.h>
#include <hip/hip_cooperative_groups.h>
#include <cstdio>
#include <cstdint>
namespace cg = cooperative_groups;
namespace pg8 {
#define PG8_LAS __attribute__((address_space(3)))
typedef unsigned short bf16_t;
typedef short bf16x8 __attribute__((ext_vector_type(8)));
typedef float f32x4 __attribute__((ext_vector_type(4)));
typedef unsigned u32x4 __attribute__((ext_vector_type(4)));
constexpr int BM = 256, BK = 64, HALF = 128, HTB = HALF * BK * 2  , STAGE_BYTES = 8 * HTB, NXCD = 8, WGM = 4;

__host__ __device__ __forceinline__ int lds_byte(int r, int c) { const int st = (r >> 4) * 2 + (c >> 5), rr = r & 15, cc = c & 31, ob = rr * 64 + cc * 2; return st * 1024 + (ob ^ (((ob >> 9) & 1) << 5)); }
__host__ __device__ __forceinline__ void stage_rc(int b, int& R, int& C) { const int st = b / 1024, sb = b % 1024, swz = sb ^ (((sb >> 9) & 1) << 5); R = (st >> 1) * 16 + swz / 64; C = (st & 1) * 32 + (swz % 64) / 2; }
__host__ __device__ __forceinline__ int perm32(int rho) { const int n = rho >> 4, i = rho & 15; return 8 * (i >> 2) + 4 * n + (i & 3); }

struct Unit { int pm, pn; };
struct Gemm { const bf16_t* A; const bf16_t* Bt; int M, N, K; };

struct StaticOrder {
    int nM, nN, nwg, G, c;
    __host__ __device__ void init(int M, int N, int G_, int c_) { nM = M / BM; nN = N / BM; nwg = nM * nN; G = G_; c = c_; }
    __host__ __device__ bool next(int i, Unit& u) const {
        const long L = (long)i * G + c; if (L >= nwg) return false;
        int wgid = (int)L; { const int q = nwg / NXCD, r = nwg % NXCD, xcd = wgid % NXCD, off = wgid / NXCD; wgid = (xcd < r ? xcd * (q + 1) : r * (q + 1) + (xcd - r) * q) + off; }
        const int nig = WGM * nN, gid = wgid / nig, fm = gid * WGM, gsz = (nM - fm) < WGM ? (nM - fm) : WGM;
        u.pm = fm + ((wgid % nig) % gsz); u.pn = (wgid % nig) / gsz; return true;
    }
    __device__ __forceinline__ void a_ready(const Unit&) const {}
    __device__ __forceinline__ void done(const Unit&) const {}
};

__device__ __forceinline__ unsigned cvt_pk_bf16(float lo, float hi) { unsigned r; asm volatile("v_cvt_pk_bf16_f32 %0, %1, %2" : "=v"(r) : "v"(lo), "v"(hi)); return r; }
typedef float f32x2 __attribute__((ext_vector_type(2)));
__device__ __forceinline__ f32x2 gelu_pk(f32x2 v) {
    const f32x2 av = __builtin_elementwise_abs(v), d = av * 0.2316418882f + 1.0f;
    f32x2 t; t.x = __builtin_amdgcn_rcpf(d.x); t.y = __builtin_amdgcn_rcpf(d.y);
    f32x2 q = t * 0.5307027145f + (-0.7265760135f); q = q * t + 0.7107068705f; q = q * t + (-0.142248368f); q = q * t + 0.127414796f; q = q * t;
    const f32x2 s = (v * v) * (-0.72134752044f);
    f32x2 e; e.x = __builtin_amdgcn_exp2f(s.x); e.y = __builtin_amdgcn_exp2f(s.y);
    const f32x2 m = v * (q * e), r = v - m;
    f32x2 o; o.x = v.x < 0.f ? m.x : r.x; o.y = v.y < 0.f ? m.y : r.y; return o;
}

template <int ACT  > struct EpiBf16 {
    static constexpr bool PERM = true, AFTER_DRAIN = false; static_assert(ACT == 0 || ACT == 1, "EpiBf16: ACT is 0 (none) or 1 (gelu_pk)");
    bf16_t* O; int ldc; const float* bias; int split_cols; size_t split_stride; float scale0;
    __device__ __forceinline__ void operator()(const f32x4 (&acc)[2][2][4][2], const Unit& u, int wr, int wc, int fr, int fq) const {
        const int row0 = u.pm * BM + wr * 64 + fr; int colt = u.pn * BM; bf16_t* base = O;
        float sc = 1.f; if (split_cols) { const int t = colt / split_cols; base += (size_t)t * split_stride; colt -= t * split_cols; if (t == 0) sc = scale0; }
        const int col0 = colt + wc * 32 + 8 * fq, bcol0 = u.pn * BM + wc * 32 + 8 * fq;
        f32x4 bv[2][2];
#pragma unroll
        for (int bj = 0; bj < 2; ++bj)
#pragma unroll
            for (int n = 0; n < 2; ++n) bv[bj][n] = bias ? *(const f32x4*)(bias + bcol0 + bj * HALF + 4 * n) : (f32x4){0.f, 0.f, 0.f, 0.f};
#pragma unroll
        for (int ai = 0; ai < 2; ++ai)
#pragma unroll
            for (int m = 0; m < 4; ++m) { bf16_t* rowp = base + (size_t)(row0 + ai * HALF + m * 16) * ldc + col0;
#pragma unroll
                for (int bj = 0; bj < 2; ++bj) { f32x4 v0 = acc[ai][bj][m][0] + bv[bj][0], v1 = acc[ai][bj][m][1] + bv[bj][1];
                    if (ACT == 1) { f32x2 a = gelu_pk((f32x2){v0[0], v0[1]}), b = gelu_pk((f32x2){v0[2], v0[3]}), c = gelu_pk((f32x2){v1[0], v1[1]}), d = gelu_pk((f32x2){v1[2], v1[3]});
                        v0 = (f32x4){a.x, a.y, b.x, b.y}; v1 = (f32x4){c.x, c.y, d.x, d.y}; }
                    v0 = v0 * sc; v1 = v1 * sc; u32x4 w; w.x = cvt_pk_bf16(v0[0], v0[1]); w.y = cvt_pk_bf16(v0[2], v0[3]); w.z = cvt_pk_bf16(v1[0], v1[1]); w.w = cvt_pk_bf16(v1[2], v1[3]);
                    *(u32x4*)(rowp + bj * HALF) = w; } }
    }
};

template <class Epi, class Sched, bool ALIGN_EPI = false, bool SP2 = false>
__device__ __forceinline__ void gemm_phase(PG8_LAS unsigned char* lds, const Gemm g, const Sched& S, const Epi& E) {
    int tid_ = threadIdx.x; asm volatile("" : "+v"(tid_)); const int tid = tid_, wid = __builtin_amdgcn_readfirstlane(tid >> 6), lane = tid & 63, wr = wid >> 2, wc = wid & 3, fr = lane & 15, fq = lane >> 4;
    const int K = g.K, nt = K / BK;
    unsigned voffA[2], voffB[2];
#pragma unroll
    for (int i = 0; i < 2; ++i) { int R, C; stage_rc(tid * 16 + i * 8192, R, C); const int Rb = Epi::PERM ? ((R & ~31) + perm32(R & 31)) : R;
        voffA[i] = (unsigned)(R * K + C) * 2u; voffB[i] = (unsigned)(Rb * K + C) * 2u; }
    const size_t kstep = (size_t)(BK * 2);
    const size_t hstep = (size_t)HALF * K * 2;
    const size_t tstep = 2 * hstep;
    const unsigned ldsw = (unsigned)wid * 1024u;
    const int aoff = lds_byte(wr * 64 + fr, fq * 8), boff = lds_byte(wc * 32 + fr, fq * 8);
#define PG8_SA(b, h) (((b) * 2 + (h)) * HTB)
#define PG8_SB(b, h) ((4 + (b) * 2 + (h)) * HTB)
#define PG8_STAGE(bufoff, gbase, voff) do { _Pragma("unroll") for (int _i = 0; _i < 2; ++_i) \
        __builtin_amdgcn_global_load_lds((const unsigned*)((const char*)(gbase) + (voff)[_i]), (PG8_LAS unsigned*)(lds + (bufoff) + ldsw + _i * 8192), 16, 0, 0); } while (0)
#define PG8_LDA(dst, b, h) do { _Pragma("unroll") for (int m = 0; m < 4; ++m) _Pragma("unroll") for (int k = 0; k < 2; ++k) dst[m][k] = *(const PG8_LAS bf16x8*)(lds + PG8_SA(b, h) + aoff + m * 2048 + k * 1024); } while (0)
#define PG8_LDB(dst, b, h) do { _Pragma("unroll") for (int n = 0; n < 2; ++n) _Pragma("unroll") for (int k = 0; k < 2; ++k) dst[n][k] = *(const PG8_LAS bf16x8*)(lds + PG8_SB(b, h) + boff + n * 2048 + k * 1024); } while (0)
#define PG8_MMA(ai, bj, At, Bt) do { __builtin_amdgcn_s_setprio(1); _Pragma("unroll") for (int m = 0; m < 4; ++m) _Pragma("unroll") for (int n = 0; n < 2; ++n) _Pragma("unroll") for (int k = 0; k < 2; ++k) \
        acc[ai][bj][m][n] = __builtin_amdgcn_mfma_f32_16x16x32_bf16(Bt[n][k], At[m][k], acc[ai][bj][m][n], 0, 0, 0); __builtin_amdgcn_s_setprio(0); } while (0)
#define PG8_WAIT_V(n) asm volatile("s_waitcnt vmcnt(" #n ")" ::: "memory")
#define PG8_WAIT_L(n) asm volatile("s_waitcnt lgkmcnt(" #n ")" ::: "memory")
#define PG8_BAR __builtin_amdgcn_s_barrier()
#define PG8_SCHED __builtin_amdgcn_sched_barrier(0)
    Unit cur, nxt; int ui = 0;
    if (!S.next(0, cur)) return;
    f32x4 acc[2][2][4][2];
#pragma unroll
    for (int a = 0; a < 2; ++a)
#pragma unroll
        for (int b = 0; b < 2; ++b)
#pragma unroll
            for (int m = 0; m < 4; ++m)
#pragma unroll
                for (int n = 0; n < 2; ++n) acc[a][b][m][n] = (f32x4){0.f, 0.f, 0.f, 0.f};
    bf16x8 At[4][2], B0[2][2], B1[2][2];
    const char* cA = (const char*)g.A + (size_t)cur.pm * tstep; const char* cB = (const char*)g.Bt + (size_t)cur.pn * tstep;
    S.a_ready(cur);
    if constexpr (SP2) {
        PG8_STAGE(PG8_SB(0, 0), cB, voffB); PG8_STAGE(PG8_SB(0, 1), cB + hstep, voffB); PG8_STAGE(PG8_SA(0, 0), cA, voffA); PG8_STAGE(PG8_SA(0, 1), cA + hstep, voffA);
        if (wr == 1) PG8_BAR;
        PG8_WAIT_V(2); PG8_BAR;
        PG8_STAGE(PG8_SB(1, 0), cB + kstep, voffB); PG8_STAGE(PG8_SA(1, 0), cA + kstep, voffA); PG8_STAGE(PG8_SB(1, 1), cB + hstep + kstep, voffB);
        PG8_WAIT_V(6); PG8_BAR;
    } else {
        PG8_STAGE(PG8_SB(0, 0), cB, voffB); PG8_STAGE(PG8_SA(0, 0), cA, voffA); PG8_STAGE(PG8_SB(0, 1), cB + hstep, voffB); PG8_STAGE(PG8_SA(0, 1), cA + hstep, voffA);
        if (wr == 1) PG8_BAR;
        PG8_WAIT_V(4); PG8_BAR;
        PG8_STAGE(PG8_SB(1, 0), cB + kstep, voffB); PG8_STAGE(PG8_SA(1, 0), cA + kstep, voffA); PG8_STAGE(PG8_SB(1, 1), cB + hstep + kstep, voffB);
        PG8_WAIT_V(6); PG8_BAR;
    }
    for (;;) {
        const bool has_next = S.next(ui + 1, nxt);
        const char* nA = has_next ? (const char*)g.A + (size_t)nxt.pm * tstep : cA; const char* nB = has_next ? (const char*)g.Bt + (size_t)nxt.pn * tstep : cB;
        for (int t = 0; t < nt; t += 2) {
            const bool last = (t == nt - 2);
            const char* a1 = cA + (size_t)(t + 1) * kstep;
            const char* a2 = last ? nA : cA + (size_t)(t + 2) * kstep; const char* b2 = last ? nB : cB + (size_t)(t + 2) * kstep;
            const char* a3 = a2 + kstep; const char* b3 = b2 + kstep;
            if (last && has_next) S.a_ready(nxt);
            if constexpr (SP2) {
            PG8_LDB(B0, 0, 0); PG8_LDB(B1, 0, 1); PG8_SCHED; PG8_LDA(At, 0, 0); PG8_STAGE(PG8_SA(1, 1), a1 + hstep, voffA);
            PG8_WAIT_V(8); PG8_WAIT_L(0); PG8_BAR; PG8_MMA(0, 0, At, B0); PG8_MMA(0, 1, At, B1); PG8_BAR; PG8_SCHED;
            PG8_LDA(At, 0, 1); PG8_STAGE(PG8_SB(0, 0), b2, voffB); PG8_STAGE(PG8_SB(0, 1), b2 + hstep, voffB); PG8_STAGE(PG8_SA(0, 0), a2, voffA);
            PG8_WAIT_V(8); PG8_WAIT_L(0); PG8_BAR; PG8_MMA(1, 0, At, B0); PG8_MMA(1, 1, At, B1); PG8_BAR; PG8_SCHED;
            PG8_LDB(B0, 1, 0); PG8_LDB(B1, 1, 1); PG8_SCHED; PG8_LDA(At, 1, 0); PG8_STAGE(PG8_SA(0, 1), a2 + hstep, voffA);
            PG8_WAIT_V(8); PG8_WAIT_L(0); PG8_BAR; PG8_MMA(0, 0, At, B0); PG8_MMA(0, 1, At, B1); PG8_BAR; PG8_SCHED;
            PG8_LDA(At, 1, 1); PG8_STAGE(PG8_SB(1, 0), b3, voffB); PG8_STAGE(PG8_SB(1, 1), b3 + hstep, voffB); PG8_STAGE(PG8_SA(1, 0), a3, voffA);
            PG8_WAIT_V(8); PG8_WAIT_L(0); PG8_BAR; PG8_MMA(1, 0, At, B0); PG8_MMA(1, 1, At, B1); PG8_BAR; PG8_SCHED;
            } else {
            PG8_LDB(B0, 0, 0); PG8_SCHED; PG8_LDA(At, 0, 0); PG8_STAGE(PG8_SA(1, 1), a1 + hstep, voffA);
            PG8_WAIT_L(8); PG8_BAR; PG8_WAIT_L(0); PG8_MMA(0, 0, At, B0); PG8_BAR; PG8_SCHED;
            PG8_LDB(B1, 0, 1); PG8_STAGE(PG8_SB(0, 0), b2, voffB);
            PG8_BAR; PG8_WAIT_L(0); PG8_MMA(0, 1, At, B1); PG8_BAR;
            PG8_LDA(At, 0, 1); PG8_STAGE(PG8_SA(0, 0), a2, voffA);
            PG8_BAR; PG8_WAIT_L(0); PG8_MMA(1, 0, At, B0); PG8_BAR; PG8_SCHED;
            PG8_STAGE(PG8_SB(0, 1), b2 + hstep, voffB);
            PG8_WAIT_V(6); PG8_BAR; PG8_MMA(1, 1, At, B1); PG8_BAR;
            PG8_LDB(B0, 1, 0); PG8_SCHED; PG8_LDA(At, 1, 0); PG8_STAGE(PG8_SA(0, 1), a2 + hstep, voffA);
            PG8_WAIT_L(8); PG8_BAR; PG8_WAIT_L(0); PG8_MMA(0, 0, At, B0); PG8_BAR; PG8_SCHED;
            PG8_LDB(B1, 1, 1); PG8_STAGE(PG8_SB(1, 0), b3, voffB);
            PG8_BAR; PG8_WAIT_L(0); PG8_MMA(0, 1, At, B1); PG8_BAR;
            PG8_LDA(At, 1, 1); PG8_STAGE(PG8_SA(1, 0), a3, voffA);
            PG8_BAR; PG8_WAIT_L(0); PG8_MMA(1, 0, At, B0); PG8_BAR; PG8_SCHED;
            PG8_STAGE(PG8_SB(1, 1), b3 + hstep, voffB);
            PG8_WAIT_V(6); PG8_BAR; PG8_MMA(1, 1, At, B1); PG8_BAR;
            }
        }
        if constexpr (ALIGN_EPI) { if (wr == 0) PG8_BAR; }
        if constexpr (!Epi::AFTER_DRAIN) { E(acc, cur, wr, wc, fr, fq); S.done(cur); }
        if (!has_next) break;
#pragma unroll
        for (int a = 0; a < 2; ++a)
#pragma unroll
            for (int b = 0; b < 2; ++b)
#pragma unroll
                for (int m = 0; m < 4; ++m)
#pragma unroll
                    for (int n = 0; n < 2; ++n) acc[a][b][m][n] = (f32x4){0.f, 0.f, 0.f, 0.f};
        cur = nxt; cA = nA; cB = nB; ++ui;
        if constexpr (ALIGN_EPI) { if (wr == 1) PG8_BAR; }
    }
    PG8_WAIT_V(0);
    if constexpr (!ALIGN_EPI) { if (wr == 0) PG8_BAR; }
    PG8_BAR;
    if constexpr (Epi::AFTER_DRAIN) { E.fused(acc, cur, wr, wc, fr, fq, lds, wid, lane); S.done(cur); }
#undef PG8_SA
#undef PG8_SB
#undef PG8_STAGE
#undef PG8_LDA
#undef PG8_LDB
#undef PG8_MMA
#undef PG8_WAIT_V
#undef PG8_WAIT_L
#undef PG8_BAR
#undef PG8_SCHED
}
}

typedef unsigned short bf16;
typedef float f32x4 __attribute__((ext_vector_type(4)));
typedef short bf16x8 __attribute__((ext_vector_type(8)));
typedef short bf16x4 __attribute__((ext_vector_type(4)));
typedef unsigned u32x4 __attribute__((ext_vector_type(4)));
typedef unsigned u32x2 __attribute__((ext_vector_type(2)));
typedef float f32x2_t __attribute__((ext_vector_type(2)));
typedef __bf16 bf16x2_t __attribute__((ext_vector_type(2)));

constexpr int DM = 2048, NCTX_ROWS = 4096, M_ROWS = 36864, NP = 6656, NMOD = 6144;
constexpr int C_AQ = 0, C_AK = 1024, C_AV = 1280, C_AG = 1536, C_BQ = 2560, C_BFF = 3072, C_BFB = 3584, C_BI = 4096, C_BG = 4608, C_CU = 5120, C_CV = 5632, C_CG = 6144;
constexpr size_t MiB = 1u << 20;
constexpr size_t WS_CTL = 0, WS_ROPE = 4096, WS_MOD = 32768, WS_WIN = 1 * MiB, WS_WOUT = 53 * MiB, WS_H = 70 * MiB, WS_P = 214 * MiB, WS_O = 682 * MiB, WS_SLOC = 826 * MiB, WS_DLOG = 858 * MiB, WS_KC = 859 * MiB, WS_VCT = 863 * MiB, WS_END = 867 * MiB;
constexpr size_t OUT_Y = 0, OUT_K = 75497472, OUT_V = 77594624, OUT_S = 79691776;
constexpr int LDS_BYTES = 147456 + 256, LDS_BCAST = 147456;
constexpr float EPSN = 1e-6f, LOG2E = 1.4426950408889634f;
constexpr int N_HL = 256, N_AL = 1024, N_AC = 128, N_HC = 64, N_SG = 288;

struct Prm {
    const float *x_prompt, *x_sample, *cache_k, *cache_v, *state, *c, *c_ctx, *norm_g, *w_ada, *b_ada, *w_in, *qg, *kg, *sink, *hlb, *hg, *lng, *lnb, *sgw, *sgb, *w_out;
    float* out; unsigned char* ws;
};

__device__ __forceinline__ float bf2f(unsigned u) { return __builtin_bit_cast(float, u << 16); }
__device__ __forceinline__ unsigned cvtpk(float lo, float hi) { f32x2_t v = {lo, hi}; bf16x2_t b = __builtin_convertvector(v, bf16x2_t); return __builtin_bit_cast(unsigned, b); }
__device__ __forceinline__ unsigned short f2bf1(float f) { return (unsigned short)(cvtpk(f, 0.f) & 0xffffu); }
__device__ __forceinline__ void unpack8(u32x4 v, float* o) {
    o[0] = bf2f(v.x & 0xffffu); o[1] = __builtin_bit_cast(float, v.x & 0xffff0000u); o[2] = bf2f(v.y & 0xffffu); o[3] = __builtin_bit_cast(float, v.y & 0xffff0000u);
    o[4] = bf2f(v.z & 0xffffu); o[5] = __builtin_bit_cast(float, v.z & 0xffff0000u); o[6] = bf2f(v.w & 0xffffu); o[7] = __builtin_bit_cast(float, v.w & 0xffff0000u);
}
__device__ __forceinline__ u32x4 pack8(const float* x) { u32x4 r; r.x = cvtpk(x[0], x[1]); r.y = cvtpk(x[2], x[3]); r.z = cvtpk(x[4], x[5]); r.w = cvtpk(x[6], x[7]); return r; }
__device__ __forceinline__ bf16x8 pack8f(f32x4 a, f32x4 b) { u32x4 r; r.x = cvtpk(a[0], a[1]); r.y = cvtpk(a[2], a[3]); r.z = cvtpk(b[0], b[1]); r.w = cvtpk(b[2], b[3]); return __builtin_bit_cast(bf16x8, r); }
__device__ __forceinline__ bf16x8 ld_perm(const bf16* p) {
    u32x2 a = *(const u32x2*)p, b = *(const u32x2*)(p + 16); u32x4 r; r.x = a.x; r.y = a.y; r.z = b.x; r.w = b.y; return __builtin_bit_cast(bf16x8, r);
}
__device__ __forceinline__ int perm32(int k) { return ((k & 12) << 1) + (k & 3) + ((k & 16) >> 2); }
__device__ __forceinline__ float silu_f(float x) { return x * __builtin_amdgcn_rcpf(1.f + __expf(-x)); }
template <int M> __device__ __forceinline__ float shx(float v, int lane) {
    if constexpr (M < 32) return __builtin_bit_cast(float, __builtin_amdgcn_ds_swizzle(__builtin_bit_cast(int, v), (M << 10) | 0x1f));
    else return __builtin_bit_cast(float, __builtin_amdgcn_ds_bpermute((lane ^ 32) << 2, __builtin_bit_cast(int, v)));
}
__device__ __forceinline__ f32x4 mfma16(bf16x8 a, bf16x8 b, f32x4 c) { return __builtin_amdgcn_mfma_f32_16x16x32_bf16(a, b, c, 0, 0, 0); }
__device__ __forceinline__ const float* xrow_ptr(const float* xp, const float* xs, int m) { return m < NCTX_ROWS ? xp + (size_t)m * DM : xs + (size_t)(m - NCTX_ROWS) * DM; }
__device__ __forceinline__ int mod_index(int m) { return m < NCTX_ROWS ? 0 : 1 + ((m - NCTX_ROWS) >> 12); }

__device__ __forceinline__ void transpose_item(const float* W, int K, int N, bf16* WT, float* scr, int item, int lane) {
    const int nblk = N / 32, kb = item / nblk, nb = item % nblk, k0 = 64 * kb, n0 = 32 * nb;
    float tv[32];
#pragma unroll
    for (int i = 0; i < 32; ++i) tv[i] = W[(size_t)(k0 + 2 * i + (lane >> 5)) * N + n0 + (lane & 31)];
#pragma unroll
    for (int i = 0; i < 32; ++i) scr[(2 * i + (lane >> 5)) * 33 + (lane & 31)] = tv[i];
    __builtin_amdgcn_s_waitcnt(0); __builtin_amdgcn_wave_barrier();
    const int c = lane & 7;
#pragma unroll
    for (int j = 0; j < 4; ++j) { const int n = (lane >> 3) + 8 * j; const float* s = scr + (8 * c) * 33 + n;
        u32x4 o; o.x = cvtpk(s[0 * 33], s[1 * 33]); o.y = cvtpk(s[2 * 33], s[3 * 33]); o.z = cvtpk(s[4 * 33], s[5 * 33]); o.w = cvtpk(s[6 * 33], s[7 * 33]);
        *(u32x4*)(WT + (size_t)(n0 + n) * K + k0 + 8 * c) = o; }
    __builtin_amdgcn_s_waitcnt(0); __builtin_amdgcn_wave_barrier();
}

__device__ __forceinline__ void phase0(const Prm& p, unsigned char* lds) {
    int tid_ = threadIdx.x; asm volatile("" : "+v"(tid_)); const int tid = tid_, lane = tid & 63, w = tid >> 6, G = gridDim.x;
    float* mod = (float*)(p.ws + WS_MOD);
    for (int g = blockIdx.x; g < 192; g += G) {
        float* sc = (float*)lds; float* red = (float*)(lds + 73728);
        __syncthreads();
        for (int e = tid; e < 9 * 2048; e += 512) { const int j = e >> 11, k = e & 2047; const float v = j == 0 ? p.c_ctx[k] : p.c[(j - 1) * 2048 + k]; sc[e] = silu_f(v); }
        __syncthreads();
        const int l = g / 96, cgp = g % 96, col = cgp * 64 + lane;
        float acc[9];
#pragma unroll
        for (int j = 0; j < 9; ++j) acc[j] = 0.f;
        const float* wp = p.w_ada + (size_t)l * 2048 * NMOD + (size_t)(w * 256) * NMOD + col;
#pragma unroll 32
        for (int k = 0; k < 256; ++k) { const float wv = wp[(size_t)k * NMOD];
#pragma unroll
            for (int j = 0; j < 9; ++j) acc[j] += sc[j * 2048 + w * 256 + k] * wv; }
#pragma unroll
        for (int j = 0; j < 9; ++j) red[(w * 9 + j) * 64 + lane] = acc[j];
        __syncthreads();
        for (int e = tid; e < 576; e += 512) { const int j = e >> 6, ln = e & 63; float s = 0.f;
#pragma unroll
            for (int ww = 0; ww < 8; ++ww) s += red[(ww * 9 + j) * 64 + ln];
            mod[(l * 9 + j) * NMOD + cgp * 64 + ln] = s + p.b_ada[l * NMOD + cgp * 64 + ln]; }
    }
    __syncthreads();
    {   bf16* Kc = (bf16*)(p.ws + WS_KC); bf16* Vct = (bf16*)(p.ws + WS_VCT);
        for (int u = blockIdx.x * 512 + tid; u < 262144; u += G * 512) {
            const f32x4 a = *(const f32x4*)(p.cache_k + (size_t)u * 8), bq = *(const f32x4*)(p.cache_k + (size_t)u * 8 + 4);
            u32x4 o; o.x = cvtpk(a.x, a.y); o.y = cvtpk(a.z, a.w); o.z = cvtpk(bq.x, bq.y); o.w = cvtpk(bq.z, bq.w); *(u32x4*)(Kc + (size_t)u * 8) = o;
            const int dd = u & 127, kg8 = (u >> 7) & 7, blk = u >> 10; const float* vs = p.cache_v + (size_t)blk * 8192 + (size_t)(kg8 * 8) * 128 + dd;
            float v[8];
#pragma unroll
            for (int i = 0; i < 8; ++i) v[i] = vs[i * 128];
            const u32x4 pk = pack8(v); bf16* vrow = Vct + (size_t)blk * 8192 + dd * 64 + ((kg8 * 8) & 32);
            u32x2 lo2, hi2; lo2.x = pk.x; lo2.y = pk.y; hi2.x = pk.z; hi2.y = pk.w;
            *(u32x2*)(vrow + perm32((kg8 * 8) & 31)) = lo2; *(u32x2*)(vrow + perm32(((kg8 * 8) & 31) + 4)) = hi2; }
    }
    float* scr = (float*)(lds + w * 16384);
    const int gw = blockIdx.x * 8 + w, NGW = G * 8;
    constexpr int I_IN = 32 * 208, I_OUT = 32 * 64, NIT = 2 * (I_IN + I_OUT);
    for (int it = gw; it < NIT; it += NGW) {
        int r = it;
        if (r < 2 * I_IN) { const int l = r / I_IN; r -= l * I_IN; transpose_item(p.w_in + (size_t)l * 2048 * NP, 2048, NP, (bf16*)(p.ws + WS_WIN) + (size_t)l * NP * 2048, scr, r, lane); }
        else { r -= 2 * I_IN; const int l = r / I_OUT; r -= l * I_OUT; transpose_item(p.w_out + (size_t)l * 2048 * 2048, 2048, 2048, (bf16*)(p.ws + WS_WOUT) + (size_t)l * 2048 * 2048, scr, r, lane); }
    }
}

__device__ __forceinline__ void phase_norm(const Prm& p, int l, const float* xp, const float* xs) {
    int tid_ = threadIdx.x; asm volatile("" : "+v"(tid_)); const int tid = tid_, lane = tid & 63, w = tid >> 6;
    const int gw = blockIdx.x * 8 + w, NGW = gridDim.x * 8, RPW = (M_ROWS + NGW - 1) / NGW;
    const float* mod = (const float*)(p.ws + WS_MOD) + (size_t)l * 9 * NMOD;
    bf16* H = (bf16*)(p.ws + WS_H);
    f32x4 A[8], B[8]; int curj = -1;
    const int m1 = min(M_ROWS, (gw + 1) * RPW);
    f32x4 v[8], vn[8];
    int m = gw * RPW;
    if (m < m1) { const f32x4* xr = (const f32x4*)xrow_ptr(xp, xs, m) + lane;
#pragma unroll
        for (int i = 0; i < 8; ++i) v[i] = __builtin_nontemporal_load(xr + 64 * i); }
    for (; m < m1; ++m) {
        const int j = mod_index(m);
        if (j != curj) { curj = j;
#pragma unroll
            for (int i = 0; i < 8; ++i) { const int c = 4 * (lane + 64 * i); const f32x4 g = *(const f32x4*)(p.norm_g + l * DM + c); const f32x4 sh = *(const f32x4*)(mod + j * NMOD + c), scl = *(const f32x4*)(mod + j * NMOD + 2048 + c);
                A[i] = g * (scl + 1.f); B[i] = sh; } }
        if (m + 1 < m1) { const f32x4* xr = (const f32x4*)xrow_ptr(xp, xs, m + 1) + lane;
#pragma unroll
            for (int i = 0; i < 8; ++i) vn[i] = __builtin_nontemporal_load(xr + 64 * i); }
        float ss = 0.f;
#pragma unroll
        for (int i = 0; i < 8; ++i) ss += (v[i].x * v[i].x + v[i].y * v[i].y) + (v[i].z * v[i].z + v[i].w * v[i].w);
        ss += shx<1>(ss, lane); ss += shx<2>(ss, lane); ss += shx<4>(ss, lane); ss += shx<8>(ss, lane); ss += shx<16>(ss, lane); ss += shx<32>(ss, lane);
        const float rstd = rsqrtf(ss * (1.f / DM) + EPSN);
        u32x2* o8 = (u32x2*)(H + (size_t)m * DM) + lane;
#pragma unroll
        for (int i = 0; i < 8; ++i) { const f32x4 y = v[i] * rstd * A[i] + B[i]; u32x2 o; o.x = cvtpk(y.x, y.y); o.y = cvtpk(y.z, y.w); o8[64 * i] = o; }
#pragma unroll
        for (int i = 0; i < 8; ++i) v[i] = vn[i];
    }
}

struct EpiResid {
    static constexpr bool PERM = true, AFTER_DRAIN = false;
    const float* xp; const float* xs; float* out; const float* mod;
    __device__ __forceinline__ void operator()(const pg8::f32x4 (&acc)[2][2][4][2], const pg8::Unit& u, int wr, int wc, int fr, int fq) const {
        const int j = u.pm < 16 ? 0 : 1 + ((u.pm - 16) >> 4);
        const float* gate = mod + j * NMOD + 4096;
        const int col0 = u.pn * 256 + wc * 32 + 8 * fq;
        f32x4 gv[2][2];
#pragma unroll
        for (int bj = 0; bj < 2; ++bj)
#pragma unroll
            for (int n = 0; n < 2; ++n) gv[bj][n] = *(const f32x4*)(gate + col0 + bj * 128 + 4 * n);
#pragma unroll
        for (int ai = 0; ai < 2; ++ai)
#pragma unroll
            for (int m = 0; m < 4; ++m) { const int row = u.pm * 256 + ai * 128 + wr * 64 + m * 16 + fr;
                const float* xin = xrow_ptr(xp, xs, row); float* o = out + (size_t)row * DM;
#pragma unroll
                for (int bj = 0; bj < 2; ++bj)
#pragma unroll
                    for (int n = 0; n < 2; ++n) { const int c = col0 + bj * 128 + 4 * n; const f32x4 xv = *(const f32x4*)(xin + c); *(f32x4*)(o + c) = xv + gv[bj][n] * acc[ai][bj][m][n]; } }
    }
};

__device__ __forceinline__ void qk_norm_rope(float* x1, float* x2, const float* gam, int d1, bool rope, const float* cs, const float* sn, float scale) {
    float ss = 0.f;
#pragma unroll
    for (int i = 0; i < 8; ++i) ss += x1[i] * x1[i] + x2[i] * x2[i];
    ss += shx<1>(ss, 0); ss += shx<2>(ss, 0); ss += shx<4>(ss, 0);
    const float rstd = rsqrtf(ss * (1.f / 128.f) + EPSN);
#pragma unroll
    for (int i = 0; i < 8; ++i) { float a = x1[i] * rstd * gam[d1 + i], b = x2[i] * rstd * gam[d1 + 32 + i];
        if (rope) { const float ra = a * cs[i] - b * sn[i], rb = b * cs[i] + a * sn[i]; a = ra; b = rb; }
        x1[i] = a * scale; x2[i] = b * scale; }
}

__device__ __forceinline__ void attn_item(const Prm& p, int l, bool lat, int b, int kvh, int qb, unsigned char* lds) {
    int tid_ = threadIdx.x; asm volatile("" : "+v"(tid_)); const int tid = tid_, lane = tid & 63, w = tid >> 6, fr = lane & 15, q4 = lane >> 4;
    const int T = lat ? 4096 : 256, rowbase = lat ? NCTX_ROWS + b * 4096 : b * 256, q0 = qb * 64;
    const bf16* P = (const bf16*)(p.ws + WS_P); bf16* MIX = (bf16*)(p.ws + WS_H);
    const bf16* Kc = (const bf16*)(p.ws + WS_KC); const bf16* Vct = (const bf16*)(p.ws + WS_VCT);
    bf16* Qs = (bf16*)(lds + 71680);
    const float* qg = p.qg + l * 128; const float* kg = p.kg + l * 128;
    const int ki8 = tid >> 3, u8 = tid & 7, ax = u8 >> 2, fg = u8 & 3, d1 = ax * 64 + fg * 8;
#define AT_FREQ(i) __builtin_amdgcn_exp2f(-(float)(2 * (fg * 8 + (i))) * (13.287712379549449f / 64.f))
    int i_lo = 0, nloc = 4, ncache = 0;
    if (lat) { i_lo = q0 >= 128 ? 0 : (128 - q0) >> 6; const int i_hi = min(4, (T + 64 - q0) >> 6); nloc = i_hi - i_lo + 1; ncache = 8; }
    const int nb = nloc + ncache;
    const size_t cbase = ((((size_t)b * 2 + l) * 2 + kvh) * 8) * 8192;
    u32x4 rA0, rA1, rA2, rA3;
#define AT_KP0(j) (lat ? q0 - 128 + 64 * (i_lo + (j)) : 64 * (j))
#define AT_LOAD(j, r0, r1, r2, r3) do { if ((j) < nloc) { const int kp0_ = AT_KP0(j); \
            const bf16* ks_ = P + (size_t)(rowbase + kp0_ + ki8) * NP + C_AK + kvh * 128 + d1; r0 = *(const u32x4*)ks_; r1 = *(const u32x4*)(ks_ + 32); \
            const bf16* vs_ = P + (size_t)(rowbase + kp0_ + (tid & 63)) * NP + C_AV + kvh * 128 + (tid >> 6) * 16; r2 = *(const u32x4*)vs_; r3 = *(const u32x4*)(vs_ + 8); } \
        else { const size_t o_ = cbase + (size_t)((j) - nloc) * 8192 + tid * 8; r0 = *(const u32x4*)(Kc + o_); r1 = *(const u32x4*)(Kc + o_ + 4096); r2 = *(const u32x4*)(Vct + o_); r3 = *(const u32x4*)(Vct + o_ + 4096); } } while (0)
#define AT_WRITE(j, Ks, Vt, r0, r1, r2, r3) do { if ((j) < nloc) { const int kp0_ = AT_KP0(j); const int t_ = kp0_ + ki8, pos_ = ax ? (t_ & 63) : (t_ >> 6); \
            float cs_[8], sn_[8], x1_[8], x2_[8]; \
            _Pragma("unroll") for (int i = 0; i < 8; ++i) { const float a_ = (float)pos_ * AT_FREQ(i); cs_[i] = __cosf(a_); sn_[i] = __sinf(a_); } \
            unpack8(r0, x1_); unpack8(r1, x2_); qk_norm_rope(x1_, x2_, kg, d1, lat, cs_, sn_, 1.f); \
            *(u32x4*)((Ks) + ki8 * 136 + d1) = pack8(x1_); *(u32x4*)((Ks) + ki8 * 136 + d1 + 32) = pack8(x2_); \
            if (!lat && (j) == qb) { int tz_ = t_ * 128 + d1; asm volatile("" : "+v"(tz_)); float* ko = p.out + OUT_K + ((((size_t)b * 2 + l) * 2 + kvh) * 256) * 128 + tz_; \
                *(f32x4*)ko = (f32x4){x1_[0], x1_[1], x1_[2], x1_[3]}; *(f32x4*)(ko + 4) = (f32x4){x1_[4], x1_[5], x1_[6], x1_[7]}; \
                *(f32x4*)(ko + 32) = (f32x4){x2_[0], x2_[1], x2_[2], x2_[3]}; *(f32x4*)(ko + 36) = (f32x4){x2_[4], x2_[5], x2_[6], x2_[7]}; } \
            const int kiv_ = tid & 63, dg_ = tid >> 6; float v_[16]; unpack8(r2, v_); unpack8(r3, v_ + 8); \
            const int kpos_ = (kiv_ & 32) + perm32(kiv_ & 31); \
            _Pragma("unroll") for (int i = 0; i < 16; ++i) (Vt)[(dg_ * 16 + i) * 72 + kpos_] = f2bf1(v_[i]); \
            if (!lat && (j) == qb) { int kz_ = (kp0_ + kiv_) * 128 + dg_ * 16; asm volatile("" : "+v"(kz_)); float* vo = p.out + OUT_V + ((((size_t)b * 2 + l) * 2 + kvh) * 256) * 128 + kz_; \
                _Pragma("unroll") for (int i = 0; i < 4; ++i) *(f32x4*)(vo + 4 * i) = (f32x4){v_[4 * i], v_[4 * i + 1], v_[4 * i + 2], v_[4 * i + 3]}; } } \
        else { *(u32x4*)((Ks) + (tid >> 4) * 136 + (tid & 15) * 8) = r0; *(u32x4*)((Ks) + (32 + (tid >> 4)) * 136 + (tid & 15) * 8) = r1; \
            *(u32x4*)((Vt) + (tid >> 3) * 72 + (tid & 7) * 8) = r2; *(u32x4*)((Vt) + (64 + (tid >> 3)) * 72 + (tid & 7) * 8) = r3; } } while (0)
    __syncthreads();
    AT_LOAD(0, rA0, rA1, rA2, rA3);
    {
        const int t = q0 + ki8, pos = ax ? (t & 63) : (t >> 6);
        float cs[8], sn[8];
#pragma unroll
        for (int i = 0; i < 8; ++i) { const float a = (float)pos * AT_FREQ(i); cs[i] = __cosf(a); sn[i] = __sinf(a); }
#pragma unroll
        for (int g = 0; g < 4; ++g) {
            const bf16* src = P + (size_t)(rowbase + t) * NP + C_AQ + (kvh * 4 + g) * 128 + d1;
            float x1[8], x2[8]; unpack8(__builtin_nontemporal_load((const u32x4*)src), x1); unpack8(__builtin_nontemporal_load((const u32x4*)(src + 32)), x2);
            qk_norm_rope(x1, x2, qg, d1, lat, cs, sn, 0.08838834764831845f * LOG2E);
            *(u32x4*)(Qs + (g * 64 + ki8) * 136 + d1) = pack8(x1); *(u32x4*)(Qs + (g * 64 + ki8) * 136 + d1 + 32) = pack8(x2);
        }
    }
    AT_WRITE(0, (bf16*)lds, (bf16*)lds + 8704, rA0, rA1, rA2, rA3);
    if (1 < nb) AT_LOAD(1, rA0, rA1, rA2, rA3);
    __syncthreads();
    const int g = w >> 1, qh = w & 1, head = kvh * 4 + g;
    bf16x8 qfr[2][4];
    {   const bf16* Qw = Qs + (g * 64 + qh * 32 + fr) * 136 + q4 * 8;
#pragma unroll
        for (int ks = 0; ks < 4; ++ks) { qfr[0][ks] = *(const bf16x8*)(Qw + ks * 32); qfr[1][ks] = *(const bf16x8*)(Qw + 16 * 136 + ks * 32); } }
    if (1 < nb) AT_WRITE(1, (bf16*)lds + 17920, (bf16*)lds + 17920 + 8704, rA0, rA1, rA2, rA3);
    __syncthreads();
    f32x4 O[8][2];
#pragma unroll
    for (int dt = 0; dt < 8; ++dt) { O[dt][0] = (f32x4){0.f, 0.f, 0.f, 0.f}; O[dt][1] = (f32x4){0.f, 0.f, 0.f, 0.f}; }
    const float sk = p.sink[l * 8 + head] * LOG2E;
    const float nsk = -sk; float lsum[2] = {q4 == 0 ? 1.f : 0.f, q4 == 0 ? 1.f : 0.f};
#define AT_COMPUTE(j, KsP, VtP) do { const bf16* Ks = (KsP); const bf16* Vt = (VtP); \
        f32x4 sT[4][2]; \
_Pragma("unroll") \
        for (int mt = 0; mt < 4; ++mt) { sT[mt][0] = (f32x4){nsk, nsk, nsk, nsk}; sT[mt][1] = (f32x4){nsk, nsk, nsk, nsk}; } \
_Pragma("unroll") \
        for (int ks = 0; ks < 4; ++ks) { const bf16x8 q0f = qfr[0][ks], q1f = qfr[1][ks]; \
_Pragma("unroll") \
            for (int mt = 0; mt < 4; ++mt) { const bf16x8 kf = *(const bf16x8*)(Ks + (mt * 16 + fr) * 136 + ks * 32 + q4 * 8); \
                sT[mt][0] = mfma16(kf, q0f, sT[mt][0]); sT[mt][1] = mfma16(kf, q1f, sT[mt][1]); } } \
        if (lat && j < nloc && (i_lo + j == 0 || i_lo + j == 4)) { const int kp0 = AT_KP0(j); \
_Pragma("unroll") \
            for (int mt = 0; mt < 4; ++mt) \
_Pragma("unroll") \
                for (int nt = 0; nt < 2; ++nt) \
_Pragma("unroll") \
                    for (int i = 0; i < 4; ++i) { const int kpos = kp0 + mt * 16 + q4 * 4 + i, qpos = q0 + qh * 32 + nt * 16 + fr; const int dd = kpos - qpos; \
                        if (dd > 128 || dd < -128) sT[mt][nt][i] = -1e30f; } \
        } \
        bf16x8 pf[2][2]; \
_Pragma("unroll") \
        for (int nt = 0; nt < 2; ++nt) { \
            float ps = 0.f; \
_Pragma("unroll") \
            for (int mt = 0; mt < 4; ++mt) \
_Pragma("unroll") \
                for (int i = 0; i < 4; ++i) { const float pv = __builtin_amdgcn_exp2f(sT[mt][nt][i]); sT[mt][nt][i] = pv; ps += pv; } \
            lsum[nt] += ps; \
            pf[nt][0] = pack8f(sT[0][nt], sT[1][nt]); pf[nt][1] = pack8f(sT[2][nt], sT[3][nt]); \
        } \
_Pragma("unroll") \
        for (int kk = 0; kk < 2; ++kk) \
_Pragma("unroll") \
            for (int dt = 0; dt < 8; ++dt) { const bf16x8 vf = *(const bf16x8*)(Vt + (dt * 16 + fr) * 72 + 32 * kk + q4 * 8); \
                O[dt][0] = mfma16(vf, pf[0][kk], O[dt][0]); O[dt][1] = mfma16(vf, pf[1][kk], O[dt][1]); } \
    } while (0)
    for (int jj = 0; jj < nb; jj += 2) {
        const int pp = (jj >> 1) & 1;
        bf16* c0 = (bf16*)(lds + (2 * pp) * 35840); bf16* c1 = c0 + 17920; bf16* n0 = (bf16*)(lds + (2 - 2 * pp) * 35840); bf16* n1 = n0 + 17920;
        if (jj + 2 < nb) AT_LOAD(jj + 2, rA0, rA1, rA2, rA3);
        AT_COMPUTE(jj, c0, c0 + 8704);
        if (jj + 2 < nb) AT_WRITE(jj + 2, n0, n0 + 8704, rA0, rA1, rA2, rA3);
        if (jj + 1 < nb) {
            if (jj + 3 < nb) AT_LOAD(jj + 3, rA0, rA1, rA2, rA3);
            AT_COMPUTE((jj + 1), c1, c1 + 8704);
            if (jj + 3 < nb) AT_WRITE(jj + 3, n1, n1 + 8704, rA0, rA1, rA2, rA3);
        }
        __syncthreads();
    }
#undef AT_COMPUTE
#undef AT_KP0
#undef AT_FREQ
#undef AT_LOAD
#undef AT_WRITE
#pragma unroll
    for (int nt = 0; nt < 2; ++nt) {
        float lt = lsum[nt]; lt += shx<16>(lt, 0); lt += shx<32>(lt, lane);
        const float inv = __builtin_amdgcn_rcpf(lt);
        const int row = rowbase + q0 + qh * 32 + nt * 16 + fr;
#pragma unroll
        for (int dt = 0; dt < 8; ++dt) { const int d = dt * 16 + q4 * 4;
            const u32x2 gv = __builtin_nontemporal_load((const u32x2*)(P + (size_t)row * NP + C_AG + head * 128 + d));
            const float g0 = bf2f(gv.x & 0xffffu), g1 = __builtin_bit_cast(float, gv.x & 0xffff0000u), g2 = bf2f(gv.y & 0xffffu), g3 = __builtin_bit_cast(float, gv.y & 0xffff0000u);
            u32x2 o; o.x = cvtpk(O[dt][nt][0] * inv * silu_f(g0), O[dt][nt][1] * inv * silu_f(g1)); o.y = cvtpk(O[dt][nt][2] * inv * silu_f(g2), O[dt][nt][3] * inv * silu_f(g3));
            *(u32x2*)(MIX + (size_t)row * DM + head * 128 + d) = o; }
    }
}

__device__ __forceinline__ float rcp_f(float x) { return __builtin_amdgcn_rcpf(x); }
__device__ __forceinline__ void hgrn_item(const Prm& p, int l, int s, int h, int seg, int mode, unsigned char* lds) {
    int tid_ = threadIdx.x; asm volatile("" : "+v"(tid_)); const int tid = tid_, lane = tid & 63, w = tid >> 6, fr = lane & 15, q4 = lane >> 4;
    const bool lat = mode != 0, do_out = mode != 1; const int b = lat ? s - 16 : s, T = lat ? 4096 : 256, rowbase = lat ? NCTX_ROWS + b * 4096 : b * 256, nCh = lat ? 16 : 8;
    const bf16* P = (const bf16*)(p.ws + WS_P); bf16* MIX = (bf16*)(p.ws + WS_H); bf16* Ob = (bf16*)(p.ws + WS_O);
    const int dir = w >> 2, sl = w & 3, dtid = tid & 255, d = dtid & 127, th = dtid >> 7;
    const int sseg = lat ? ((dir && mode == 2) ? 7 - seg : seg) : 0, c0 = sseg * 16;
    unsigned char* L = lds + dir * 65536;
    const bf16* rawZ = (const bf16*)L; const bf16* rawQ = (const bf16*)(L + 8192); const bf16* rawV = (const bf16*)(L + 16384);
    bf16* qe = (bf16*)(L + 24576); bf16* ke = (bf16*)(L + 33280); bf16* kdT = (bf16*)(L + 41984); bf16* vT = (bf16*)(L + 52224); float* eb = (float*)(L + 62464); float* tot = (float*)(L + 62976);
    float lb = 0.f;
    if (l == 1) { const float x0 = p.hlb[(0 * 2 + dir) * 512 + h * 128 + d], x1 = p.hlb[(1 * 2 + dir) * 512 + h * 128 + d]; lb = rcp_f(1.f + __expf(x0 - x1)); }
    const float omlb = 1.f - lb;
    unsigned* dep = (unsigned*)(p.ws + WS_CTL) + 256 + (l * 32 + b * 4 + h);
    if (mode == 2) {
        if (w == 0) { if (lane == 0) { while (__hip_atomic_load(dep, __ATOMIC_RELAXED, __HIP_MEMORY_SCOPE_AGENT) < 7u) __builtin_amdgcn_s_sleep(8); }
            __builtin_amdgcn_fence(__ATOMIC_ACQUIRE, "agent"); }
        __syncthreads();
    }
    f32x4 S[8][2];
    const size_t sbase = ((((size_t)b * 2 + l) * 2 + dir) * 4 + h) * 16384;
    float* sloc = (float*)(p.ws + WS_SLOC) + ((((size_t)b * 4 + h) * 2 + dir) * 8) * 16384;
    float* dlg = (float*)(p.ws + WS_DLOG) + ((((size_t)b * 4 + h) * 2 + dir) * 8) * 128;
    const int soff = sl * 32 + fr;
#pragma unroll
    for (int dm = 0; dm < 8; ++dm) { S[dm][0] = (f32x4){0.f, 0.f, 0.f, 0.f}; S[dm][1] = (f32x4){0.f, 0.f, 0.f, 0.f}; }
    if (mode == 2) {
        const float* stp = p.state + sbase + q4 * 512 + soff; asm volatile("" : "+v"(stp));
#pragma unroll
        for (int dm = 0; dm < 8; ++dm)
#pragma unroll
            for (int nn = 0; nn < 2; ++nn)
#pragma unroll
                for (int i = 0; i < 4; ++i) S[dm][nn][i] = stp[(dm * 16 + i) * 128 + nn * 16];
        for (int j = 0; j < sseg; ++j) {
            const float* sp = sloc + (size_t)j * 16384 + q4 * 512 + soff; asm volatile("" : "+v"(sp));
            const float* dp = dlg + j * 128 + q4 * 4; asm volatile("" : "+v"(dp));
#pragma unroll
            for (int dm = 0; dm < 8; ++dm) { const f32x4 dl = *(const f32x4*)(dp + dm * 16);
#pragma unroll
                for (int nn = 0; nn < 2; ++nn)
#pragma unroll
                    for (int i = 0; i < 4; ++i) S[dm][nn][i] = S[dm][nn][i] * __builtin_amdgcn_exp2f(dl[i]) + sp[(dm * 16 + i) * 128 + nn * 16]; }
        }
    }
    bf16* Od = Ob + (size_t)dir * M_ROWS * 512;
    float dacc = 0.f;
    const int zc0 = (dir ? C_BFB : C_BFF) + h * 128, qc0 = C_BQ + h * 128, vc0 = C_BI + h * 128;
    const int ur = dtid >> 4, uc = (dtid & 15) * 8;
    u32x4 pre[6];
#define HG_LOAD(cidx) do { const int cr_ = rowbase + (dir ? T - 32 * ((cidx) + 1) : 32 * (cidx)); \
        _Pragma("unroll") for (int k = 0; k < 2; ++k) { const bf16* pr_ = P + (size_t)(cr_ + ur + 16 * k) * NP + uc; \
            pre[k] = *(const u32x4*)(pr_ + zc0); pre[2 + k] = *(const u32x4*)(pr_ + vc0); if (do_out) pre[4 + k] = *(const u32x4*)(pr_ + qc0); } } while (0)
#define HG_STORE() do { _Pragma("unroll") for (int k = 0; k < 2; ++k) { const int o_ = (ur + 16 * k) * 128 + uc; \
            *(u32x4*)(L + 2 * o_) = pre[k]; *(u32x4*)(L + 16384 + 2 * o_) = pre[2 + k]; if (do_out) *(u32x4*)(L + 8192 + 2 * o_) = pre[4 + k]; } } while (0)
    __syncthreads();
    HG_LOAD(c0); HG_STORE();
    if (nCh > 1) HG_LOAD(c0 + 1);
    __syncthreads();
    for (int cc = 0; cc < nCh; ++cc) {
        const int c = c0 + cc;
        const int crow0 = rowbase + (dir ? T - 32 * (c + 1) : 32 * c);
        float Fp[16], kk[16]; unsigned qpk[8], vpk[8]; float runa = 1.f, runb = 1.f;
#pragma unroll
        for (int ii = 0; ii < 16; ++ii) { const int i = (ii < 8 ? th * 8 + ii : 8 + th * 8 + ii), ro = (dir ? 31 - i : i) * 128 + d;
            const unsigned vz = rawV[ro], qz = rawQ[ro];
            if (ii & 1) { vpk[ii >> 1] |= vz << 16; qpk[ii >> 1] |= qz << 16; } else { vpk[ii >> 1] = vz; qpk[ii >> 1] = qz; }
            float z = bf2f(rawZ[ro]);
            z = fminf(fmaxf(z, -60.f), 60.f);
            const float e = __expf(-z), sg = rcp_f(1.f + e), f = lb + omlb * sg;
            if (ii < 8) { runa *= f; Fp[ii] = runa; } else { runb *= f; Fp[ii] = runb; }
            kk[ii] = omlb * (e * sg); }
        tot[th * 128 + d] = runa; tot[(2 + th) * 128 + d] = runb;
        __syncthreads();
        {   const float oa = tot[(1 - th) * 128 + d], ob = tot[(3 - th) * 128 + d];
            const float offa = th ? oa : 1.f;
            const float offb = th ? oa * runa * ob : runa * oa;
            const float Flast = runa * runb * oa * ob;
            const int pd = (d & ~31) + perm32(d & 31);
#pragma unroll
            for (int hh = 0; hh < 2; ++hh) {
                float kd[8];
#pragma unroll
                for (int x = 0; x < 8; ++x) { const int ii = (x < 4 ? 4 * hh + x : 8 + 4 * hh + (x - 4));
                    const float Fx = Fp[ii] * (ii < 8 ? offa : offb), rx = rcp_f(Fx); kd[x] = kk[ii] * (Flast * rx); kk[ii] *= rx; Fp[ii] = Fx; }
                u32x4 w0; w0.x = cvtpk(kd[0], kd[1]); w0.y = cvtpk(kd[2], kd[3]); w0.z = cvtpk(kd[4], kd[5]); w0.w = cvtpk(kd[6], kd[7]);
                *(u32x4*)(kdT + d * 40 + th * 16 + 8 * hh) = w0;
                u32x4 v0; v0.x = vpk[2 * hh]; v0.y = vpk[2 * hh + 1]; v0.z = vpk[4 + 2 * hh]; v0.w = vpk[4 + 2 * hh + 1];
                *(u32x4*)(vT + d * 40 + th * 16 + 8 * hh) = v0; }
            if (do_out) {
#pragma unroll
                for (int ii = 0; ii < 16; ii += 2) { const int i = (ii < 8 ? th * 8 + ii : 8 + th * 8 + ii);
                    const float q0 = bf2f(qpk[ii >> 1] & 0xffffu), q1 = __builtin_bit_cast(float, qpk[ii >> 1] & 0xffff0000u);
                    qe[i * 136 + pd] = f2bf1(silu_f(q0) * Fp[ii]); qe[(i + 1) * 136 + pd] = f2bf1(silu_f(q1) * Fp[ii + 1]);
                    ke[i * 136 + pd] = f2bf1(kk[ii]); ke[(i + 1) * 136 + pd] = f2bf1(kk[ii + 1]); } }
            if (th == 0) { eb[d] = Flast; dacc += __log2f(Flast); } }
        if (cc + 1 < nCh) HG_STORE();
        __syncthreads();
        bf16x8 vf[2];
#pragma unroll
        for (int nn = 0; nn < 2; ++nn) vf[nn] = *(const bf16x8*)(vT + (sl * 32 + nn * 16 + fr) * 40 + q4 * 8);
        if (do_out) {
            f32x4 aT[2][2], o[2][2];
#pragma unroll
            for (int x = 0; x < 2; ++x) { aT[x][0] = (f32x4){0.f, 0.f, 0.f, 0.f}; aT[x][1] = (f32x4){0.f, 0.f, 0.f, 0.f}; o[x][0] = (f32x4){0.f, 0.f, 0.f, 0.f}; o[x][1] = (f32x4){0.f, 0.f, 0.f, 0.f}; }
#pragma unroll
            for (int ks = 0; ks < 4; ++ks) {
                const bf16x8 q0f = *(const bf16x8*)(qe + fr * 136 + ks * 32 + q4 * 8), q1f = *(const bf16x8*)(qe + (16 + fr) * 136 + ks * 32 + q4 * 8);
                const bf16x8 k0f = *(const bf16x8*)(ke + fr * 136 + ks * 32 + q4 * 8), k1f = *(const bf16x8*)(ke + (16 + fr) * 136 + ks * 32 + q4 * 8);
                aT[0][0] = mfma16(k0f, q0f, aT[0][0]); aT[0][1] = mfma16(k0f, q1f, aT[0][1]); aT[1][0] = mfma16(k1f, q0f, aT[1][0]); aT[1][1] = mfma16(k1f, q1f, aT[1][1]);
#pragma unroll
                for (int nn = 0; nn < 2; ++nn) { const bf16x8 sf = pack8f(S[2 * ks][nn], S[2 * ks + 1][nn]);
                    o[0][nn] = mfma16(sf, q0f, o[0][nn]); o[1][nn] = mfma16(sf, q1f, o[1][nn]); }
            }
#pragma unroll
            for (int mt = 0; mt < 2; ++mt)
#pragma unroll
                for (int nt = 0; nt < 2; ++nt)
#pragma unroll
                    for (int i = 0; i < 4; ++i) if (mt * 16 + q4 * 4 + i > nt * 16 + fr) aT[mt][nt][i] = 0.f;
#pragma unroll
            for (int tt = 0; tt < 2; ++tt) { const bf16x8 af = pack8f(aT[0][tt], aT[1][tt]);
                o[tt][0] = mfma16(vf[0], af, o[tt][0]); o[tt][1] = mfma16(vf[1], af, o[tt][1]); }
#pragma unroll
            for (int tt = 0; tt < 2; ++tt) { const int t = tt * 16 + fr, r = dir ? 31 - t : t; bf16* ob_ = Od + (size_t)(crow0 + r) * 512 + h * 128 + sl * 32 + q4 * 4;
#pragma unroll
                for (int nn = 0; nn < 2; ++nn) { u32x2 ov; ov.x = cvtpk(o[tt][nn][0], o[tt][nn][1]); ov.y = cvtpk(o[tt][nn][2], o[tt][nn][3]); *(u32x2*)(ob_ + nn * 16) = ov; } }
        }
        if (cc + 2 < nCh) HG_LOAD(c + 2);
#pragma unroll
        for (int dm = 0; dm < 8; ++dm) { const bf16x8 kdf = *(const bf16x8*)(kdT + (dm * 16 + fr) * 40 + q4 * 8); const f32x4 e4 = *(const f32x4*)(eb + dm * 16 + q4 * 4);
            S[dm][0] = mfma16(kdf, vf[0], S[dm][0] * e4); S[dm][1] = mfma16(kdf, vf[1], S[dm][1] * e4); }
    }
#undef HG_LOAD
#undef HG_STORE
    if (mode != 2) {
        float* so = (mode == 0 ? p.out + OUT_S + sbase : sloc + (size_t)sseg * 16384) + q4 * 512 + soff; asm volatile("" : "+v"(so));
#pragma unroll
        for (int dm = 0; dm < 8; ++dm)
#pragma unroll
            for (int nn = 0; nn < 2; ++nn)
#pragma unroll
                for (int i = 0; i < 4; ++i) __hip_atomic_store(so + (dm * 16 + i) * 128 + nn * 16, S[dm][nn][i], __ATOMIC_RELAXED, __HIP_MEMORY_SCOPE_AGENT);
        if (mode == 1 && th == 0) __hip_atomic_store(dlg + sseg * 128 + d, dacc, __ATOMIC_RELAXED, __HIP_MEMORY_SCOPE_AGENT);
        if (mode == 1) { asm volatile("s_waitcnt vmcnt(0)" ::: "memory"); __syncthreads(); if (tid == 0) __hip_atomic_fetch_add(dep, 1u, __ATOMIC_RELAXED, __HIP_MEMORY_SCOPE_AGENT); }
    }
    if (do_out) {
        asm volatile("s_waitcnt vmcnt(0)" ::: "memory");
        __syncthreads();
        const int rr = tid >> 4, part = tid & 15; const float* hg = p.hg + l * 128 + part * 8;
        float hgv[8];
#pragma unroll
        for (int i = 0; i < 8; ++i) hgv[i] = hg[i];
        const int r0 = rowbase + (lat ? seg * 512 : 0), nIt = lat ? 4 : 2;
        for (int it = 0; it < nIt; ++it) {
            u32x4 af4[4], bf4[4], gt4[4];
#pragma unroll
            for (int k = 0; k < 4; ++k) { const int row = r0 + it * 128 + k * 32 + rr; const bf16* a = Ob + (size_t)row * 512 + h * 128 + part * 8;
                af4[k] = __builtin_nontemporal_load((const u32x4*)a); bf4[k] = __builtin_nontemporal_load((const u32x4*)(a + (size_t)M_ROWS * 512));
                gt4[k] = __builtin_nontemporal_load((const u32x4*)(P + (size_t)row * NP + C_BG + h * 128 + part * 8)); }
#pragma unroll
            for (int k = 0; k < 4; ++k) { const int row = r0 + it * 128 + k * 32 + rr;
                float ov[8], ob8[8]; unpack8(af4[k], ov); unpack8(bf4[k], ob8);
#pragma unroll
                for (int i = 0; i < 8; ++i) ov[i] += ob8[i];
                float ss = 0.f;
#pragma unroll
                for (int i = 0; i < 8; ++i) ss += ov[i] * ov[i];
                ss += shx<1>(ss, 0); ss += shx<2>(ss, 0); ss += shx<4>(ss, 0); ss += shx<8>(ss, 0);
                const float rstd = rsqrtf(ss * (1.f / 128.f) + EPSN);
                float gt[8]; unpack8(gt4[k], gt);
#pragma unroll
                for (int i = 0; i < 8; ++i) ov[i] = ov[i] * rstd * hgv[i] * (gt[i] * rcp_f(1.f + __expf(-gt[i])));
                *(u32x4*)(MIX + (size_t)row * DM + 1024 + h * 128 + part * 8) = pack8(ov); }
        }
    }
}

__device__ __forceinline__ void hgrnA_item(const Prm& p, int l, int s, int h, int seg, unsigned char* lds) {
    int tid_ = threadIdx.x; asm volatile("" : "+v"(tid_)); const int tid = tid_, lane = tid & 63, w = tid >> 6, fr = lane & 15, q4 = lane >> 4;
    const int b = s - 16, rowbase = NCTX_ROWS + b * 4096, T = 4096;
    const bf16* P = (const bf16*)(p.ws + WS_P);
    const int dir = w >> 2, sl = w & 3, dtid = tid & 255, col = dtid & 127; const bool zthr = dir ? dtid >= 128 : dtid < 128;
    const int c0 = seg * 16;
    unsigned char* L = lds + dir * 73728;
    float lb = 0.f;
    if (l == 1) { const float x0 = p.hlb[(0 * 2 + dir) * 512 + h * 128 + col], x1 = p.hlb[(1 * 2 + dir) * 512 + h * 128 + col]; lb = rcp_f(1.f + __expf(x0 - x1)); }
    const float omlb = 1.f - lb;
    f32x4 S[8][2];
#pragma unroll
    for (int dm = 0; dm < 8; ++dm) { S[dm][0] = (f32x4){0.f, 0.f, 0.f, 0.f}; S[dm][1] = (f32x4){0.f, 0.f, 0.f, 0.f}; }
    const int zc0 = (dir ? C_BFB : C_BFF) + h * 128, vc0 = C_BI + h * 128;
    const int ur = dtid >> 4, uc = (dtid & 15) * 8;
    u32x4 pre[4];
#define HA_ROW0(k) (rowbase + (dir ? T - 32 * ((c0 + 15 - (k)) + 1) : 32 * (c0 + 15 - (k))))
#define HA_LOAD(k) do { const int cr_ = HA_ROW0(k); _Pragma("unroll") for (int x = 0; x < 2; ++x) { const bf16* pr_ = P + (size_t)(cr_ + ur + 16 * x) * NP + uc; \
        pre[x] = *(const u32x4*)(pr_ + zc0); pre[2 + x] = *(const u32x4*)(pr_ + vc0); } } while (0)
#define HA_STORE(buf) do { unsigned char* R_ = L + (buf) * 16384; _Pragma("unroll") for (int x = 0; x < 2; ++x) { const int o_ = (ur + 16 * x) * 128 + uc; \
        *(u32x4*)(R_ + 2 * o_) = pre[x]; *(u32x4*)(R_ + 8192 + 2 * o_) = pre[2 + x]; } } while (0)
    float G = 1.f;
#define HA_PREP(k) do { const bf16* rz_ = (const bf16*)(L + ((k) & 1) * 16384); const bf16* rv_ = rz_ + 4096; bf16* kdT_ = (bf16*)(L + 32768 + ((k) & 1) * 20480); bf16* vT_ = kdT_ + 5120; \
        if (zthr) { _Pragma("unroll") for (int g8 = 0; g8 < 4; ++g8) { float kd_[8]; \
                _Pragma("unroll") for (int x = 0; x < 8; ++x) { const int st_ = g8 * 8 + x, r_ = dir ? st_ : 31 - st_;     \
                    float z_ = bf2f(rz_[r_ * 128 + col]); z_ = fminf(fmaxf(z_, -60.f), 60.f); const float e_ = __expf(-z_), sg_ = rcp_f(1.f + e_); \
                    kd_[x] = omlb * (e_ * sg_) * G; G *= lb + omlb * sg_; } \
                u32x4 w_; if (dir) { w_.x = cvtpk(kd_[0], kd_[1]); w_.y = cvtpk(kd_[2], kd_[3]); w_.z = cvtpk(kd_[4], kd_[5]); w_.w = cvtpk(kd_[6], kd_[7]); } \
                else { w_.x = cvtpk(kd_[7], kd_[6]); w_.y = cvtpk(kd_[5], kd_[4]); w_.z = cvtpk(kd_[3], kd_[2]); w_.w = cvtpk(kd_[1], kd_[0]); } \
                *(u32x4*)(kdT_ + col * 40 + (dir ? g8 * 8 : 24 - g8 * 8)) = w_; } } \
        else { _Pragma("unroll") for (int g8 = 0; g8 < 4; ++g8) { u32x4 w_; \
                w_.x = (unsigned)rv_[(g8 * 8 + 0) * 128 + col] | ((unsigned)rv_[(g8 * 8 + 1) * 128 + col] << 16); w_.y = (unsigned)rv_[(g8 * 8 + 2) * 128 + col] | ((unsigned)rv_[(g8 * 8 + 3) * 128 + col] << 16); \
                w_.z = (unsigned)rv_[(g8 * 8 + 4) * 128 + col] | ((unsigned)rv_[(g8 * 8 + 5) * 128 + col] << 16); w_.w = (unsigned)rv_[(g8 * 8 + 6) * 128 + col] | ((unsigned)rv_[(g8 * 8 + 7) * 128 + col] << 16); \
                *(u32x4*)(vT_ + col * 40 + g8 * 8) = w_; } } } while (0)
    __syncthreads();
    HA_LOAD(0); HA_STORE(0); HA_LOAD(1); HA_STORE(1);
    __syncthreads();
    HA_PREP(0);
    __syncthreads();
    for (int k = 0; k < 16; ++k) {
        if (k + 2 < 16) HA_LOAD(k + 2);
        if (k + 1 < 16) HA_PREP(k + 1);
        {   const bf16* kdT_ = (const bf16*)(L + 32768 + (k & 1) * 20480); const bf16* vT_ = kdT_ + 5120;
            bf16x8 vf[2];
#pragma unroll
            for (int nn = 0; nn < 2; ++nn) vf[nn] = *(const bf16x8*)(vT_ + (sl * 32 + nn * 16 + fr) * 40 + q4 * 8);
#pragma unroll
            for (int dm = 0; dm < 8; ++dm) { const bf16x8 kdf = *(const bf16x8*)(kdT_ + (dm * 16 + fr) * 40 + q4 * 8);
                S[dm][0] = mfma16(kdf, vf[0], S[dm][0]); S[dm][1] = mfma16(kdf, vf[1], S[dm][1]); } }
        if (k + 2 < 16) HA_STORE(k & 1);
        __syncthreads();
    }
#undef HA_ROW0
#undef HA_LOAD
#undef HA_STORE
#undef HA_PREP
    const int sseg = seg;
    float* sloc = (float*)(p.ws + WS_SLOC) + ((((size_t)b * 4 + h) * 2 + dir) * 8) * 16384;
    float* dlg = (float*)(p.ws + WS_DLOG) + ((((size_t)b * 4 + h) * 2 + dir) * 8) * 128;
    unsigned* dep = (unsigned*)(p.ws + WS_CTL) + 256 + (l * 32 + b * 4 + h);
    {   float* so_ = sloc + (size_t)sseg * 16384 + q4 * 512 + sl * 32 + fr; asm volatile("" : "+v"(so_)); float* so = so_;
#pragma unroll
        for (int dm = 0; dm < 8; ++dm)
#pragma unroll
            for (int nn = 0; nn < 2; ++nn)
#pragma unroll
                for (int i = 0; i < 4; ++i) __hip_atomic_store(so + (dm * 16 + i) * 128 + nn * 16, S[dm][nn][i], __ATOMIC_RELAXED, __HIP_MEMORY_SCOPE_AGENT);
        if (zthr) __hip_atomic_store(dlg + sseg * 128 + col, __log2f(G), __ATOMIC_RELAXED, __HIP_MEMORY_SCOPE_AGENT);
        asm volatile("s_waitcnt vmcnt(0)" ::: "memory"); __syncthreads(); if (tid == 0) __hip_atomic_fetch_add(dep, 1u, __ATOMIC_RELAXED, __HIP_MEMORY_SCOPE_AGENT); }
}

__device__ __forceinline__ void sgu_item(const Prm& p, int l, int n, unsigned char* lds) {
    int tid_ = threadIdx.x; asm volatile("" : "+v"(tid_)); const int tid = tid_, lane = tid & 63, w = tid >> 6, fr = lane & 15, q4 = lane >> 4;
    const bf16* P = (const bf16*)(p.ws + WS_P); bf16* MIX = (bf16*)(p.ws + WS_H);
    const int row0 = n * 128;
    float* stats = (float*)lds; bf16* vnT = (bf16*)(lds + 1024);
    __syncthreads();
    {   const int q = tid >> 2, part = tid & 3; const bf16* src = P + (size_t)(row0 + q) * NP + C_CV + part * 128;
        float s = 0.f, ss = 0.f;
#pragma unroll
        for (int i = 0; i < 16; ++i) { float v[8]; unpack8(*(const u32x4*)(src + 8 * i), v);
#pragma unroll
            for (int k = 0; k < 8; ++k) { s += v[k]; ss += v[k] * v[k]; } }
        s += shx<1>(s, 0); s += shx<2>(s, 0); ss += shx<1>(ss, 0); ss += shx<2>(ss, 0);
        const float mean = s * (1.f / 512.f), var = fmaxf(ss * (1.f / 512.f) - mean * mean, 0.f);
        if (part == 0) { stats[2 * q] = mean; stats[2 * q + 1] = rsqrtf(var + EPSN); } }
    __syncthreads();
    const int qp = tid >> 3, cp = tid & 7;
    const float m0 = stats[4 * qp], r0s = stats[4 * qp + 1], m1 = stats[4 * qp + 2], r1s = stats[4 * qp + 3];
    const int prow = row0 + w * 16 + fr;
    for (int g = 0; g < 4; ++g) {
        {   const bf16* s0 = P + (size_t)(row0 + 2 * qp) * NP + C_CV + g * 128 + cp * 16;
            float a[16], bq[16]; unpack8(*(const u32x4*)s0, a); unpack8(*(const u32x4*)(s0 + 8), a + 8); unpack8(*(const u32x4*)(s0 + NP), bq); unpack8(*(const u32x4*)(s0 + NP + 8), bq + 8);
            const float* gp = p.lng + l * 512 + g * 128 + cp * 16; const float* bp = p.lnb + l * 512 + g * 128 + cp * 16;
#pragma unroll
            for (int k = 0; k < 4; ++k) { const f32x4 gv = *(const f32x4*)(gp + 4 * k), bv = *(const f32x4*)(bp + 4 * k);
#pragma unroll
                for (int i = 0; i < 4; ++i) { const int c = 4 * k + i;
                    *(unsigned*)(vnT + (cp * 16 + c) * 136 + 2 * qp) = cvtpk((a[c] - m0) * r0s * gv[i] + bv[i], (bq[c] - m1) * r1s * gv[i] + bv[i]); } } }
        __syncthreads();
        bf16x8 wf[4];
        {   const float* wsrc = p.sgw + (((size_t)l * 4 + g) * 128 + w * 16 + fr) * 128 + q4 * 8;
#pragma unroll
            for (int ks = 0; ks < 4; ++ks) { const f32x4 a = *(const f32x4*)(wsrc + ks * 32), bq = *(const f32x4*)(wsrc + ks * 32 + 4); wf[ks] = pack8f(a, bq); } }
        const float bsv = p.sgb[((size_t)l * 4 + g) * 128 + w * 16 + fr];
        const bf16* pr = P + (size_t)prow * NP + g * 128 + q4 * 4;
        u32x2 uu[8], gg[8];
#pragma unroll
        for (int nt = 0; nt < 8; ++nt) { uu[nt] = *(const u32x2*)(pr + C_CU + nt * 16); gg[nt] = *(const u32x2*)(pr + C_CG + nt * 16); }
#pragma unroll
        for (int nt = 0; nt < 8; ++nt) { f32x4 acc = (f32x4){0.f, 0.f, 0.f, 0.f};
#pragma unroll
            for (int ks = 0; ks < 4; ++ks) acc = mfma16(*(const bf16x8*)(vnT + (nt * 16 + fr) * 136 + ks * 32 + q4 * 8), wf[ks], acc);
            const float u0 = bf2f(uu[nt].x & 0xffffu), u1 = __builtin_bit_cast(float, uu[nt].x & 0xffff0000u), u2 = bf2f(uu[nt].y & 0xffffu), u3 = __builtin_bit_cast(float, uu[nt].y & 0xffff0000u);
            const float g0 = bf2f(gg[nt].x & 0xffffu), g1 = __builtin_bit_cast(float, gg[nt].x & 0xffff0000u), g2 = bf2f(gg[nt].y & 0xffffu), g3 = __builtin_bit_cast(float, gg[nt].y & 0xffff0000u);
            u32x2 o; o.x = cvtpk(u0 * (acc[0] + bsv) * silu_f(g0), u1 * (acc[1] + bsv) * silu_f(g1)); o.y = cvtpk(u2 * (acc[2] + bsv) * silu_f(g2), u3 * (acc[3] + bsv) * silu_f(g3));
            *(u32x2*)(MIX + (size_t)prow * DM + 1536 + g * 128 + nt * 16 + q4 * 4) = o; }
        __syncthreads();
    }
}

#define LAS __attribute__((address_space(3)))
#define XB_TMO      128
#define XB_XCNT(j)  (256  + 64 * (j))
#define XB_XSUB(j)  (1280 + 64 * (j))
#define XB_XGEN(j)  (2304 + 64 * (j))
#define XB_TOP      3328
#define XB_TOPGEN   3392
#define XCD_BAR_WORDS 3456
#define XB_SPIN_CAP (1u << 18)

__device__ __forceinline__ unsigned xb_ld(unsigned* p)              { return __hip_atomic_load(p, __ATOMIC_RELAXED, __HIP_MEMORY_SCOPE_AGENT); }
__device__ __forceinline__ unsigned xb_add(unsigned* p, unsigned v) { return __hip_atomic_fetch_add(p, v, __ATOMIC_RELAXED, __HIP_MEMORY_SCOPE_AGENT); }
__device__ __forceinline__ unsigned xb_xcc_id() { return (unsigned)__builtin_amdgcn_s_getreg((3 << 11) | 20) & 0xFu; }
#define XB_SPIN(cond, bar) do { unsigned _sp = 0; while (cond) { __builtin_amdgcn_s_sleep(1); \
    if ((++_sp & 255u) == 0u) { if (xb_ld(&(bar)[XB_TMO])) break; if (_sp > XB_SPIN_CAP) { atomicAdd(&(bar)[XB_TMO], 1u); break; } } } } while (0)

struct XcdBarrier {
    unsigned* bar; unsigned x;
    volatile LAS unsigned* st;
};

__device__ __forceinline__ XcdBarrier xcd_barrier_post(unsigned* bar, volatile LAS unsigned* st) {
    XcdBarrier b; b.bar = bar; b.x = xb_xcc_id(); b.st = st;
    if (threadIdx.x == 0) (void)xb_add(&bar[XB_XCNT(b.x)], 1u);
    return b;
}
__device__ __forceinline__ void xcd_barrier_complete(unsigned* bar, unsigned x, unsigned& nloc, unsigned& nx) {
    const unsigned G = gridDim.x * gridDim.y * gridDim.z;
    unsigned sum, cnt, mine, sp = 0u;
    for (;;) {
        sum = 0u; cnt = 0u; mine = 0u;
#pragma unroll
        for (unsigned j = 0; j < 16; ++j) { const unsigned c = xb_ld(&bar[XB_XCNT(j)]); sum += c; cnt += (c > 0u) ? 1u : 0u; mine = (j == x) ? c : mine; }
        if (sum == G) break;
        __builtin_amdgcn_s_sleep(1);
        if ((++sp & 255u) == 0u) { if (xb_ld(&bar[XB_TMO])) break; if (sp > XB_SPIN_CAP) { atomicAdd(&bar[XB_TMO], 1u); break; } }
    }
    nloc = mine > 0u ? mine : 1u; nx = cnt > 0u ? cnt : 1u;
}

__device__ __forceinline__ void xcd_barrier(const XcdBarrier& b) {
    asm volatile("s_waitcnt vmcnt(0)" ::: "memory");
    __syncthreads();
    if (threadIdx.x == 0) {
        unsigned* bar = b.bar;
        __builtin_amdgcn_s_waitcnt(0);
        unsigned nloc = b.st[0], nx = b.st[1];
        if (nloc == 0u) { xcd_barrier_complete(bar, b.x, nloc, nx); b.st[0] = nloc; b.st[1] = nx; }
        const unsigned old = xb_add(&bar[XB_XSUB(b.x)], 1u);
        const unsigned gen = old / nloc;
        if (old + 1u == (gen + 1u) * nloc) {
            __builtin_amdgcn_fence(__ATOMIC_RELEASE, "agent");
            asm volatile("s_waitcnt vmcnt(0)" ::: "memory");
            const unsigned og = xb_add(&bar[XB_TOP], 1u);
            const unsigned tg = og / nx;
            if (og + 1u == (tg + 1u) * nx) xb_add(&bar[XB_TOPGEN], 1u);
            else XB_SPIN(xb_ld(&bar[XB_TOPGEN]) == tg, bar);
            __builtin_amdgcn_fence(__ATOMIC_ACQUIRE, "agent");
            xb_add(&bar[XB_XGEN(b.x)], 1u);
            asm volatile("s_waitcnt vmcnt(0)" ::: "memory");
        } else {
            XB_SPIN(xb_ld(&bar[XB_XGEN(b.x)]) == gen, bar);
            __builtin_amdgcn_fence(__ATOMIC_ACQUIRE, "agent");
            asm volatile("s_waitcnt vmcnt(0)" ::: "memory");
        }
    }
    __syncthreads();
}

__device__ __forceinline__ unsigned char* g_lds_base() { extern __shared__ __attribute__((aligned(16))) unsigned char lds_[]; return lds_; }
__device__ __forceinline__ void phase_mix(const Prm& p, int l, unsigned char* lds) {
    volatile int* bw = (volatile int*)(lds + LDS_BCAST);
    constexpr int E0 = 28, E1 = E0 + 8, E2 = E1 + 128, E3 = E2 + 32, E4 = E3 + 16, E5 = E4 + 36;
    const int x0 = (int)(xb_xcc_id() & 7u);
    for (int kq = 0; kq < 8; ++kq) {
        const int x = (x0 + kq) & 7;
        unsigned* ctr = (unsigned*)(p.ws + WS_CTL) + 1024 + 64 * (l * 8 + x);
        for (;;) {
            __syncthreads();
            if (threadIdx.x == 0) *bw = (int)atomicAdd(ctr, 1u);
            __syncthreads();
            int it = __builtin_amdgcn_readfirstlane(*bw);
            if (it >= E5) break;
            int type, a0, a1 = 0, a2 = 0, a3 = 0;
            if (it < E0) { type = 0; a0 = 16 + x; a1 = it / 7; a2 = it - a1 * 7; a3 = 1; }
            else if (it < E1) { it -= E0; type = 0; a0 = 2 * x + (it >> 2); a1 = it & 3; a3 = 0; }
            else if (it < E2) { it -= E1; type = 1; a0 = x; a1 = it >> 6; a2 = it & 63; }
            else if (it < E3) { it -= E2; type = 0; a0 = 16 + x; a1 = it >> 3; a2 = it & 7; a3 = 2; }
            else if (it < E4) { it -= E3; type = 2; a0 = 2 * x + (it >> 3); a1 = (it >> 2) & 1; a2 = it & 3; }
            else { type = 3; a0 = x * 36 + (it - E4); }
            if (type == 0) { if (a3 == 1) hgrnA_item(p, l, a0, a1, a2, lds); else hgrn_item(p, l, a0, a1, a2, a3, lds); }
            else if (type == 3) sgu_item(p, l, a0, lds);
            else attn_item(p, l, type == 1, a0, a1, a2, lds);
        }
    }
}

__global__ void __launch_bounds__(512) fwd_mega(Prm p) {
    extern __shared__ __attribute__((aligned(16))) unsigned char lds[];
    cg::grid_group grid = cg::this_grid();
    volatile LAS unsigned* xst = (volatile LAS unsigned*)((LAS unsigned char*)lds + LDS_BCAST + 16);
    if (threadIdx.x < 2) xst[threadIdx.x] = 0u;
    __syncthreads();
    (void)xcd_barrier_post((unsigned*)(p.ws + WS_CTL) + 2048, xst);
#define GRID_BAR() do { XcdBarrier b_; b_.bar = (unsigned*)(p.ws + WS_CTL) + 2048; b_.x = xb_xcc_id(); b_.st = (volatile LAS unsigned*)((LAS unsigned char*)g_lds_base() + LDS_BCAST + 16); xcd_barrier(b_); } while (0)
    phase0(p, lds);
    grid.sync();
#pragma unroll 1
    for (int l_ = 0; l_ < 2; ++l_) {
        int l = l_; asm volatile("" : "+s"(l));
        const float* xp = l == 0 ? p.x_prompt : p.out; const float* xs = l == 0 ? p.x_sample : p.out + (size_t)NCTX_ROWS * DM;
        phase_norm(p, l, xp, xs);
        GRID_BAR();
        {   pg8::Gemm g{(const pg8::bf16_t*)(p.ws + WS_H), (const pg8::bf16_t*)(p.ws + WS_WIN) + (size_t)l * NP * 2048, M_ROWS, NP, 2048};
            pg8::StaticOrder S; S.init(M_ROWS, NP, (int)gridDim.x, (int)blockIdx.x);
            pg8::EpiBf16<0> E{(pg8::bf16_t*)(p.ws + WS_P), NP, nullptr, 0, 0, 1.f};
            pg8::gemm_phase<pg8::EpiBf16<0>, pg8::StaticOrder, true, true>((PG8_LAS unsigned char*)lds, g, S, E); }
        GRID_BAR();
        phase_mix(p, l, lds);
        GRID_BAR();
        {   pg8::Gemm g{(const pg8::bf16_t*)(p.ws + WS_H), (const pg8::bf16_t*)(p.ws + WS_WOUT) + (size_t)l * 2048 * 2048, M_ROWS, 2048, 2048};
            pg8::StaticOrder S; S.init(M_ROWS, 2048, (int)gridDim.x, (int)blockIdx.x);
            EpiResid E{xp, xs, p.out, (const float*)(p.ws + WS_MOD) + (size_t)l * 9 * NMOD};
            pg8::gemm_phase<EpiResid, pg8::StaticOrder, true, true>((PG8_LAS unsigned char*)lds, g, S, E); }
        if (l == 0) GRID_BAR();
    }
}

extern "C" void kernel_launch(void* const* d_in, const int* in_sizes, int n_in, void* d_out, int out_size, void* d_ws, size_t ws_size, hipStream_t stream) {
    static int grid = 0;
    if (grid == 0) {
        if (n_in != 21 || ws_size < WS_END) { fprintf(stderr, "kernel_launch: unexpected n_in %d / ws_size %zu\n", n_in, ws_size); grid = -1; return; }
        int dev = 0, cus = 0, per_cu = 0;
        hipGetDevice(&dev); hipDeviceGetAttribute(&cus, hipDeviceAttributeMultiprocessorCount, dev);
        if (hipFuncSetAttribute((const void*)fwd_mega, hipFuncAttributeMaxDynamicSharedMemorySize, LDS_BYTES) != hipSuccess) { fprintf(stderr, "kernel_launch: hipFuncSetAttribute failed\n"); grid = -1; return; }
        if (hipOccupancyMaxActiveBlocksPerMultiprocessor(&per_cu, (const void*)fwd_mega, 512, LDS_BYTES) != hipSuccess || per_cu < 1) { fprintf(stderr, "kernel_launch: occupancy query %d\n", per_cu); per_cu = 1; }
        (void)hipGetLastError();
        grid = cus * 1;
    }
    if (grid < 0) return;
    hipMemsetAsync((char*)d_ws + WS_CTL, 0, 32768, stream);
    Prm p{};
    const float** pp = (const float**)&p;
    for (int i = 0; i < 21; ++i) pp[i] = (const float*)d_in[i];
    p.out = (float*)d_out; p.ws = (unsigned char*)d_ws;
    void* args[] = {&p};
    hipError_t e = hipLaunchCooperativeKernel((const void*)fwd_mega, dim3(grid), dim3(512), args, LDS_BYTES, stream);
    if (e != hipSuccess) fprintf(stderr, "cooperative launch failed: %s (grid %d)\n", hipGetErrorString(e), grid);
}
```
